# Optimizing an MI355X kernel written in HIP

```python
import jax, jax.numpy as jnp
from jax import lax
import numpy as np

D_MODEL = 1024
BATCH = 8
SEQ = 4096
DEPTH = 1
DEC_BATCH = 8
DEC_SEQ = 16
PAST_LEN = 2048

CHUNK = 64
EPS = 1e-6
D_INNER = 2 * D_MODEL
SSD_HEAD_DIM = 64
SSD_HEADS = D_INNER // SSD_HEAD_DIM
SSD_GROUPS = 8
SSD_HPG = SSD_HEADS // SSD_GROUPS
SSD_STATE = 128
CONV_WIDTH = 4
CONV_DIM = D_INNER + 2 * SSD_GROUPS * SSD_STATE
SSD_NORM_GROUP = D_INNER // SSD_GROUPS
POOL_WINDOWS = (2, 4, 8, 16)
POOL_GROUPS = len(POOL_WINDOWS)
D_POOL = D_MODEL
POOL_GROUP_DIM = D_POOL // POOL_GROUPS
POOL_HIST = max(POOL_WINDOWS) - 1
D_FF = 4 * D_MODEL
N_BRANCH = 2
SPLIT_Z = D_INNER
SPLIT_XBC = SPLIT_Z + CONV_DIM
SPLIT_DT = SPLIT_XBC + SSD_HEADS
SPLIT_POOL = SPLIT_DT + D_POOL
D_IN_PROJ = SPLIT_POOL + N_BRANCH * D_MODEL

kernel_name = 'hybrid_ssd_pool_streaming_encoder_step'


def rms_norm(x, g):
    xf = x.astype(jnp.float32)
    y = xf * lax.rsqrt(jnp.mean(xf * xf, axis=-1, keepdims=True) + EPS)
    return (y * g.astype(jnp.float32)).astype(x.dtype)


def causal_dwconv(hist, u, w, b):
    L = u.shape[1]
    up = jnp.concatenate([hist, u], axis=1)
    out = b + up[:, 0:L] * w[0]
    for k in range(1, CONV_WIDTH):
        out = out + up[:, k:k + L] * w[k]
    return out, up[:, -(CONV_WIDTH - 1):]


def ssd_chunked(x, dt, a, bm, cm, h0):
    f32 = jnp.float32
    b, L = x.shape[:2]
    cl = CHUNK if L % CHUNK == 0 else L
    nc = L // cl
    G, J, P, N = SSD_GROUPS, SSD_HPG, SSD_HEAD_DIM, SSD_STATE
    xr = (x.astype(f32) * dt[..., None]).reshape(b, nc, cl, G, J, P)
    a_cs = jnp.cumsum((dt * a).reshape(b, nc, cl, G, J), axis=2)
    br = bm.astype(f32).reshape(b, nc, cl, G, N)
    cr = cm.astype(f32).reshape(b, nc, cl, G, N)
    seg = a_cs[:, :, :, None] - a_cs[:, :, None, :]
    causal = jnp.tril(jnp.ones((cl, cl), dtype=bool))[None, None, :, :, None, None]
    decay = jnp.exp(jnp.where(causal, seg, -jnp.inf))
    cb = jnp.einsum('bclgn,bcsgn->bclsg', cr, br)
    y_diag = jnp.einsum('bclsg,bclsgj,bcsgjp->bclgjp', cb, decay, xr)
    decay_to_end = jnp.exp(a_cs[:, :, -1:] - a_cs)
    states = jnp.einsum('bclgn,bclgj,bclgjp->bcgjpn', br, decay_to_end, xr)
    chunk_decay = jnp.exp(a_cs[:, :, -1])

    def step(h, inp):
        s_c, d_c = inp
        return h * d_c[..., None, None] + s_c, h

    h_final, h_prev = lax.scan(step, h0.astype(f32),
                               (jnp.moveaxis(states, 1, 0), jnp.moveaxis(chunk_decay, 1, 0)))
    h_prev = jnp.moveaxis(h_prev, 0, 1)
    y_off = jnp.einsum('bclgn,bcgjpn,bclgj->bclgjp', cr, h_prev, jnp.exp(a_cs))
    y = (y_diag + y_off).reshape(b, L, G, J, P)
    return y, h_final


def multiscale_pool(hist, p, pos0):
    f32 = jnp.float32
    b, L, _ = p.shape
    pp = jnp.concatenate([hist, p], axis=1).astype(f32)
    cs = jnp.concatenate([jnp.zeros_like(pp[:, :1]), jnp.cumsum(pp, axis=1)], axis=1)
    pos = pos0 + jnp.arange(L)
    outs = []
    for gi, w in enumerate(POOL_WINDOWS):
        sl = slice(gi * POOL_GROUP_DIM, (gi + 1) * POOL_GROUP_DIM)
        hi = cs[:, POOL_HIST + 1:POOL_HIST + 1 + L, sl]
        lo = cs[:, POOL_HIST + 1 - w:POOL_HIST + 1 - w + L, sl]
        cnt = jnp.minimum(pos + 1, w).astype(f32)[None, :, None]
        outs.append((hi - lo) / cnt)
    mean = jnp.concatenate(outs, axis=-1)
    return (mean - p.astype(f32)).astype(p.dtype), pp[:, -POOL_HIST:].astype(p.dtype)


def encoder_layer(x, c, conv_hist, pool_hist, h0, pos0, w_ada, b_ada, g_pre_mix, g_post_mix,
                  g_pre_mlp, g_post_mlp, w_in, conv_w, conv_b, dt_bias, a_log, d_skip, g_ssd_norm,
                  w_ssd_out, w_pool_group, pool_scale, w_o, w_up, w_down):
    f32 = jnp.float32
    b, L, _ = x.shape
    mod = (jax.nn.silu(c) @ w_ada + b_ada)[:, None, :]
    sh1, sc1, gt1, sh2, sc2, gt2 = jnp.split(mod, 6, axis=-1)
    u = rms_norm(x, g_pre_mix) * (1 + sc1) + sh1
    proj = u @ w_in
    z, xbc, dt_raw, p, gates = jnp.split(proj, [SPLIT_Z, SPLIT_XBC, SPLIT_DT, SPLIT_POOL], axis=-1)
    xbc_c, conv_state = causal_dwconv(conv_hist, xbc, conv_w, conv_b)
    xbc_c = jax.nn.silu(xbc_c)
    xs, bm, cm = jnp.split(xbc_c, [D_INNER, D_INNER + SSD_GROUPS * SSD_STATE], axis=-1)
    xs = xs.reshape(b, L, SSD_GROUPS, SSD_HPG, SSD_HEAD_DIM)
    bm = bm.reshape(b, L, SSD_GROUPS, SSD_STATE)
    cm = cm.reshape(b, L, SSD_GROUPS, SSD_STATE)
    dt = jax.nn.softplus(dt_raw.astype(f32) + dt_bias.astype(f32)).reshape(b, L, SSD_GROUPS, SSD_HPG)
    a = -jnp.exp(a_log.astype(f32)).reshape(SSD_GROUPS, SSD_HPG)
    h0g = h0.reshape(b, SSD_GROUPS, SSD_HPG, SSD_HEAD_DIM, SSD_STATE)
    y, h_final = ssd_chunked(xs, dt, a, bm, cm, h0g)
    y = y + xs.astype(f32) * d_skip.astype(f32).reshape(SSD_GROUPS, SSD_HPG)[..., None]
    yg = (y.reshape(b, L, D_INNER) * jax.nn.silu(z.astype(f32))).reshape(b, L, SSD_GROUPS, SSD_NORM_GROUP)
    yg = yg * lax.rsqrt(jnp.mean(yg * yg, axis=-1, keepdims=True) + EPS)
    y_ssd = (yg.reshape(b, L, D_INNER) * g_ssd_norm.astype(f32)).astype(x.dtype) @ w_ssd_out
    pm, pool_state = multiscale_pool(pool_hist, p, pos0)
    y_pool = jnp.einsum('blgc,gcd->blgd', pm.reshape(b, L, POOL_GROUPS, POOL_GROUP_DIM),
                        w_pool_group).reshape(b, L, D_POOL) * pool_scale
    gate_ssd, gate_pool = jnp.split(jax.nn.sigmoid(gates.astype(f32)).astype(x.dtype), N_BRANCH, axis=-1)
    mix = (gate_ssd * y_ssd + gate_pool * y_pool) @ w_o
    x = x + gt1 * rms_norm(mix, g_post_mix)
    v = rms_norm(x, g_pre_mlp) * (1 + sc2) + sh2
    hdn = jnp.square(jax.nn.relu(v @ w_up))
    x = x + gt2 * rms_norm(hdn @ w_down, g_post_mlp)
    new_h = h_final.reshape(b, SSD_HEADS, SSD_HEAD_DIM, SSD_STATE).astype(x.dtype)
    return x, new_h, conv_state, pool_state


def setup_inputs(seed: int = 0) -> dict:
    key = jax.random.key(seed)
    ks = jax.random.split(key, 32)
    nrm = jax.random.normal
    f32 = jnp.float32
    dt0 = jnp.exp(jax.random.uniform(ks[13], (DEPTH, SSD_HEADS), f32, np.log(1e-3), np.log(1e-1)))
    return {
        'x_prompt': nrm(ks[0], (BATCH, SEQ, D_MODEL), f32),
        'x_sample': nrm(ks[1], (DEC_BATCH, DEC_SEQ, D_MODEL), f32),
        'state_ssm': 0.5 * nrm(ks[2], (DEPTH, DEC_BATCH, SSD_HEADS, SSD_HEAD_DIM, SSD_STATE), f32),
        'state_conv': nrm(ks[3], (DEPTH, DEC_BATCH, CONV_WIDTH - 1, CONV_DIM), f32),
        'state_pool': nrm(ks[4], (DEPTH, DEC_BATCH, POOL_HIST, D_POOL), f32),
        'c_prompt': nrm(ks[5], (BATCH, D_MODEL), f32),
        'c_sample': nrm(ks[6], (DEC_BATCH, D_MODEL), f32),
        'w_ada': 0.5 * D_MODEL ** -0.5 * nrm(ks[7], (DEPTH, D_MODEL, 6 * D_MODEL), f32),
        'b_ada': 0.01 * nrm(ks[8], (DEPTH, 6 * D_MODEL), f32),
        'g_pre_mix': 1.0 + 0.05 * nrm(ks[9], (DEPTH, D_MODEL), f32),
        'g_post_mix': 1.0 + 0.05 * nrm(ks[10], (DEPTH, D_MODEL), f32),
        'g_pre_mlp': 1.0 + 0.05 * nrm(ks[11], (DEPTH, D_MODEL), f32),
        'g_post_mlp': 1.0 + 0.05 * nrm(ks[12], (DEPTH, D_MODEL), f32),
        'w_in': D_MODEL ** -0.5 * nrm(ks[14], (DEPTH, D_MODEL, D_IN_PROJ), f32),
        'conv_w': 0.5 * nrm(ks[15], (DEPTH, CONV_WIDTH, CONV_DIM), f32),
        'conv_b': 0.01 * nrm(ks[16], (DEPTH, CONV_DIM), f32),
        'dt_bias': dt0 + jnp.log(-jnp.expm1(-dt0)),
        'a_log': jnp.log(jax.random.uniform(ks[17], (DEPTH, SSD_HEADS), f32, 1.0, 16.0)),
        'd_skip': 1.0 + 0.1 * nrm(ks[18], (DEPTH, SSD_HEADS), f32),
        'g_ssd_norm': 1.0 + 0.05 * nrm(ks[19], (DEPTH, D_INNER), f32),
        'w_ssd_out': D_INNER ** -0.5 * nrm(ks[20], (DEPTH, D_INNER, D_MODEL), f32),
        'w_pool_group': POOL_GROUP_DIM ** -0.5 * nrm(ks[21], (DEPTH, POOL_GROUPS, POOL_GROUP_DIM, POOL_GROUP_DIM), f32),
        'pool_scale': 1.0 + 0.1 * nrm(ks[22], (DEPTH, D_POOL), f32),
        'w_o': D_MODEL ** -0.5 * nrm(ks[23], (DEPTH, D_MODEL, D_MODEL), f32),
        'w_up': D_MODEL ** -0.5 * nrm(ks[24], (DEPTH, D_MODEL, D_FF), f32),
        'w_down': D_FF ** -0.5 * nrm(ks[25], (DEPTH, D_FF, D_MODEL), f32),
    }


def reference(x_prompt, x_sample, state_ssm, state_conv, state_pool, c_prompt, c_sample,
              w_ada, b_ada, g_pre_mix, g_post_mix, g_pre_mlp, g_post_mlp, w_in, conv_w, conv_b,
              dt_bias, a_log, d_skip, g_ssd_norm, w_ssd_out, w_pool_group, pool_scale, w_o, w_up, w_down):
    yp, ys = x_prompt, x_sample
    bp = x_prompt.shape[0]
    ssm_p, conv_p, pool_p, ssm_s, conv_s, pool_s = [], [], [], [], [], []
    for l in range(DEPTH):
        lw = dict(w_ada=w_ada[l], b_ada=b_ada[l], g_pre_mix=g_pre_mix[l], g_post_mix=g_post_mix[l],
                  g_pre_mlp=g_pre_mlp[l], g_post_mlp=g_post_mlp[l], w_in=w_in[l], conv_w=conv_w[l],
                  conv_b=conv_b[l], dt_bias=dt_bias[l], a_log=a_log[l], d_skip=d_skip[l],
                  g_ssd_norm=g_ssd_norm[l], w_ssd_out=w_ssd_out[l], w_pool_group=w_pool_group[l],
                  pool_scale=pool_scale[l], w_o=w_o[l], w_up=w_up[l], w_down=w_down[l])
        zc = jnp.zeros((bp, CONV_WIDTH - 1, CONV_DIM), yp.dtype)
        zp = jnp.zeros((bp, POOL_HIST, D_POOL), yp.dtype)
        zh = jnp.zeros((bp, SSD_HEADS, SSD_HEAD_DIM, SSD_STATE), yp.dtype)
        yp, h_p, c_p, p_p = encoder_layer(yp, c_prompt, zc, zp, zh, 0, **lw)
        ys, h_s, c_s, p_s = encoder_layer(ys, c_sample, state_conv[l], state_pool[l], state_ssm[l], PAST_LEN, **lw)
        ssm_p.append(h_p); conv_p.append(c_p); pool_p.append(p_p)
        ssm_s.append(h_s); conv_s.append(c_s); pool_s.append(p_s)
    return (yp, ys, jnp.stack(ssm_p), jnp.stack(conv_p), jnp.stack(pool_p),
            jnp.stack(ssm_s), jnp.stack(conv_s), jnp.stack(pool_s))
```

```cpp
#include <hip/hip_runtime.h>
#include <cstdio>
#include <cstdint>

constexpr int DM = 1024, NBATCH = 8, SEQ = 4096, DSEQ = 16;
constexpr int MP = NBATCH * SEQ;
constexpr int MS = NBATCH * DSEQ;
constexpr int MR = MP + MS;
constexpr int MPAD = 33024;
constexpr int DIN = 2048, NHEAD = 32, DFF = 4096, CONVD = 4096;
constexpr int N1A = 7424, N1B = 2048;
constexpr float EPS = 1e-6f;
constexpr size_t OFF_SSM_P = 33685504, OFF_CONV_P = 35782656, OFF_POOL_P = 35880960, OFF_SSM_S = 36003840, OFF_CONV_S = 38100992, OFF_POOL_S = 38199296;

namespace pg8 {
#define PG8_LAS __attribute__((address_space(3)))
typedef unsigned short bf16_t;
typedef short bf16x8 __attribute__((ext_vector_type(8)));
typedef float f32x4 __attribute__((ext_vector_type(4)));
typedef unsigned u32x4 __attribute__((ext_vector_type(4)));
typedef unsigned u32x2 __attribute__((ext_vector_type(2)));
constexpr int BM = 256, BK = 64, HALF = 128, HTB = HALF * BK * 2, STAGE_BYTES = 8 * HTB, NXCD = 8, WGM = 8;

__host__ __device__ __forceinline__ int lds_byte(int r, int c) { const int st = (r >> 4) * 2 + (c >> 5), rr = r & 15, cc = c & 31, ob = rr * 64 + cc * 2; return st * 1024 + (ob ^ (((ob >> 9) & 1) << 5)); }
__host__ __device__ __forceinline__ void stage_rc(int b, int& R, int& C) { const int st = b / 1024, sb = b % 1024, swz = sb ^ (((sb >> 9) & 1) << 5); R = (st >> 1) * 16 + swz / 64; C = (st & 1) * 32 + (swz % 64) / 2; }
__host__ __device__ __forceinline__ int tile_vec(int R, int C) { return (((R >> 4) * 2 + (C >> 5)) * 16 + (R & 15)) * 4 + ((C >> 3) & 3); }
__host__ __device__ __forceinline__ int perm32(int rho) { const int n = rho >> 4, i = rho & 15; return 8 * (i >> 2) + 4 * n + (i & 3); }

struct Unit { int pm, pn, kofs, nk, hn; };
__host__ __device__ __forceinline__ bool unit_half(const Unit& u) { return u.pm == 128; }
struct Gemm { const bf16_t* A; const bf16_t* Bt; int M, N, K, lda, ldb, a_pn_off; };

struct StaticOrder {
    int nM, nN, nwg, G, c;
    __host__ __device__ void init(int M, int N, int G_, int c_) { nM = M / BM; nN = N / BM; nwg = nM * nN; G = G_; c = c_; }
    __host__ __device__ bool next(int i, Unit& u) const {
        const long L = (long)i * G + c; if (L >= nwg) return false;
        int wgid = (int)L; { const int q = nwg / NXCD, r = nwg % NXCD, xcd = wgid % NXCD, off = wgid / NXCD; wgid = (xcd < r ? xcd * (q + 1) : r * (q + 1) + (xcd - r) * q) + off; }
        const int nig = WGM * nN, gid = wgid / nig, fm = gid * WGM, gsz = (nM - fm) < WGM ? (nM - fm) : WGM;
        u.pm = fm + ((wgid % nig) % gsz); u.pn = (wgid % nig) / gsz; u.kofs = 0; u.nk = 0; u.hn = 0; return true;
    }
};
template <bool REV = false> struct SplitOrderT {
    StaticOrder P; int np, nNs, ksplit, nk, G, c, ofs;
    __host__ __device__ void init(int nNp, int nNs_, int ksplit_, int nk_, int G_, int c_, int ofs_ = 0) { P.init(MP, nNp * BM, G_, c_); np = P.nwg; nNs = nNs_; ksplit = ksplit_; nk = nk_; G = G_; c = c_; ofs = ofs_; }
    __host__ __device__ bool next(int i, Unit& u) const {
        const long L = (long)i * G + c;
        if (L < np) return P.next(REV ? np / G - 1 - i : i, u);
        const int idx = (int)(L - np) - ofs; if (idx < 0 || idx >= nNs * ksplit) return false;
        u.pm = 128; u.pn = idx % nNs; const int ks = idx / nNs; u.kofs = ks * nk * BK; u.nk = ksplit > 1 ? nk : 0; u.hn = 0; return true;
    }
};

typedef SplitOrderT<false> SplitOrder; typedef SplitOrderT<true> SplitOrderRev;
struct InProjOrder {
    StaticOrder P; int G, c;
    __host__ __device__ void init(int G_, int c_) { P.init(MP, 28 * BM, G_, c_); G = G_; c = c_; }
    __host__ __device__ bool next(int i, Unit& u) const {
        const long L = (long)i * G + c;
        if (L < P.nwg) return P.next(i, u);
        int idx = (int)(L - P.nwg); u.kofs = 0; u.nk = 0;
        if (idx < 128) { u.pm = idx; u.pn = 28; u.hn = 1; return true; }
        idx -= 128; if (idx >= 37) return false;
        u.pm = 128; u.pn = idx; u.hn = idx == 28 ? 1 : 0; return true;
    }
};

typedef __bf16 bf16x2_t __attribute__((ext_vector_type(2)));
typedef float f32x2_t __attribute__((ext_vector_type(2)));
__device__ __forceinline__ unsigned cvt_pk_bf16(float lo, float hi) { const f32x2_t v = {lo, hi}; const bf16x2_t b = __builtin_convertvector(v, bf16x2_t); return __builtin_bit_cast(unsigned, b); }
__device__ __forceinline__ float bf_lo(unsigned u) { return __uint_as_float(u << 16); }
__device__ __forceinline__ float bf_hi(unsigned u) { return __uint_as_float(u & 0xffff0000u); }
__device__ __forceinline__ float silu_f(float v) { return v * __builtin_amdgcn_rcpf(1.0f + __expf(-v)); }
__device__ __forceinline__ float sigmoid_f(float v) { return __builtin_amdgcn_rcpf(1.0f + __expf(-v)); }
__device__ __forceinline__ float softplus_f(float x) { const float e = __expf(x); return x > 20.f ? x : (e < 1e-4f ? e * (1.f - 0.5f * e) : __logf(1.f + e)); }
__device__ __forceinline__ u32x4 pack8(const f32x4 a, const f32x4 b) { u32x4 w; w.x = cvt_pk_bf16(a[0], a[1]); w.y = cvt_pk_bf16(a[2], a[3]); w.z = cvt_pk_bf16(b[0], b[1]); w.w = cvt_pk_bf16(b[2], b[3]); return w; }


struct Epi1a {
    static constexpr bool PERM = true, AFTER_DRAIN = false;
    bf16_t* Z; bf16_t* XBC; bf16_t* P; float* DT; const float* dt_bias; float* out; bf16_t* GS; bf16_t* HALO;
    __device__ __forceinline__ void operator()(const f32x4 (&acc)[2][2][4][2], const Unit& u, int wr, int wc, int fr, int fq) const {
        const int pn = u.pn, row0 = u.pm * BM + wr * 64 + fr, cl0 = wc * 32 + 8 * fq;
        if (pn >= 29) {
#pragma unroll
            for (int m = 0; m < 4; ++m) { const int rl = wr * 64 + fr + m * 16;
#pragma unroll
                for (int bj = 0; bj < 2; ++bj) { f32x4 v0 = acc[0][bj][m][0], v1 = acc[0][bj][m][1];
#pragma unroll
                    for (int i = 0; i < 4; ++i) { v0[i] = sigmoid_f(v0[i]); v1[i] = sigmoid_f(v1[i]); }
                    *(u32x4*)(GS + (size_t)rl * DIN + (pn - 29) * BM + bj * HALF + cl0) = pack8(v0, v1); } }
        } else if (pn < 8) {
#pragma unroll
            for (int ai = 0; ai < 2; ++ai)
#pragma unroll
                for (int m = 0; m < 4; ++m) { const int row = row0 + ai * HALF + m * 16;
#pragma unroll
                    for (int bj = 0; bj < 2; ++bj) { f32x4 v0 = acc[ai][bj][m][0], v1 = acc[ai][bj][m][1];
#pragma unroll
                        for (int i = 0; i < 4; ++i) { v0[i] = silu_f(v0[i]); v1[i] = silu_f(v1[i]); }
                        *(u32x4*)(Z + (size_t)row * DIN + pn * BM + bj * HALF + cl0) = pack8(v0, v1); } }
        } else if (pn < 24) {
#pragma unroll
            for (int ai = 0; ai < 2; ++ai)
#pragma unroll
                for (int m = 0; m < 4; ++m) { const int row = row0 + ai * HALF + m * 16;
                    long so = -1;
                    if (row < MP) { const int t = row & (SEQ - 1); if (t >= SEQ - 3) so = (long)OFF_CONV_P + ((long)(row >> 12) * 3 + (t - (SEQ - 3))) * CONVD; }
                    else if (row < MR) { const int rs = row - MP, t = rs & 15; if (t >= DSEQ - 3) so = (long)OFF_CONV_S + ((long)(rs >> 4) * 3 + (t - (DSEQ - 3))) * CONVD; }
                    long ho = -1;
                    if (pn >= 16 && row < MP) { const int t = row & (SEQ - 1); if ((t & 511) >= 509 && t < SEQ - 512) ho = ((long)((row >> 12) * 8 + (t >> 9) + 1) * 3 + ((t & 511) - 509)) * 2048 - 2048; }
#pragma unroll
                    for (int bj = 0; bj < 2; ++bj) { const f32x4 v0 = acc[ai][bj][m][0], v1 = acc[ai][bj][m][1]; const int col = (pn - 8) * BM + bj * HALF + cl0; const u32x4 pk = pack8(v0, v1);
                        *(u32x4*)(XBC + (size_t)row * CONVD + col) = pk;
                        if (ho >= 0) *(u32x4*)(HALO + ho + col) = pk;
                        if (so >= 0) { *(f32x4*)(out + so + col) = v0; *(f32x4*)(out + so + col + 4) = v1; } } }
        } else if (pn < 28) {
#pragma unroll
            for (int ai = 0; ai < 2; ++ai)
#pragma unroll
                for (int m = 0; m < 4; ++m) { const int row = row0 + ai * HALF + m * 16;
                    long so = -1;
                    if (row < MP) { const int t = row & (SEQ - 1); if (t >= SEQ - 15) so = (long)OFF_POOL_P + ((long)(row >> 12) * 15 + (t - (SEQ - 15))) * DM; }
                    else if (row < MR) { const int rs = row - MP, t = rs & 15; if (t >= 1) so = (long)OFF_POOL_S + ((long)(rs >> 4) * 15 + (t - 1)) * DM; }
#pragma unroll
                    for (int bj = 0; bj < 2; ++bj) { const f32x4 v0 = acc[ai][bj][m][0], v1 = acc[ai][bj][m][1]; const int col = (pn - 24) * BM + bj * HALF + cl0;
                        *(u32x4*)(P + (size_t)row * DM + col) = pack8(v0, v1);
                        if (so >= 0) { *(f32x4*)(out + so + col) = v0; *(f32x4*)(out + so + col + 4) = v1; } } }
        } else {
            const int dc = 8 * wc + 2 * fq; const float b0 = dt_bias[dc], b1 = dt_bias[dc + 1];
#pragma unroll
            for (int ai = 0; ai < 2; ++ai)
#pragma unroll
                for (int m = 0; m < 4; ++m) { const int row = row0 + ai * HALF + m * 16;
                    f32x2_t o; o.x = softplus_f(acc[ai][0][m][0][0] + b0); o.y = softplus_f(acc[ai][0][m][0][1] + b1);
                    *(f32x2_t*)(DT + (size_t)row * 32 + dc) = o; }
        }
    }
};
template <int ACT> struct EpiAct {
    static constexpr bool PERM = true, AFTER_DRAIN = false;
    bf16_t* O; int ldc;
    __device__ __forceinline__ void operator()(const f32x4 (&acc)[2][2][4][2], const Unit& u, int wr, int wc, int fr, int fq) const {
        const int row0 = u.pm * BM + wr * 64 + fr, col0 = u.pn * BM + wc * 32 + 8 * fq;
#pragma unroll
        for (int ai = 0; ai < 2; ++ai)
#pragma unroll
            for (int m = 0; m < 4; ++m) { bf16_t* rowp = O + (size_t)(row0 + ai * HALF + m * 16) * ldc + col0;
#pragma unroll
                for (int bj = 0; bj < 2; ++bj) { f32x4 v0 = acc[ai][bj][m][0], v1 = acc[ai][bj][m][1];
#pragma unroll
                    for (int i = 0; i < 4; ++i) {
                        if (ACT == 1) { v0[i] = sigmoid_f(v0[i]); v1[i] = sigmoid_f(v1[i]); }
                        if (ACT == 2) { const float a = fmaxf(v0[i], 0.f), b = fmaxf(v1[i], 0.f); v0[i] = a * a; v1[i] = b * b; } }
                    *(u32x4*)(rowp + bj * HALF) = pack8(v0, v1); } }
    }
};
struct EpiHdnT {
    static constexpr bool PERM = true, AFTER_DRAIN = false;
    bf16_t* O;
    __device__ __forceinline__ void operator()(const f32x4 (&acc)[2][2][4][2], const Unit& u, int wr, int wc, int fr, int fq) const {
        bf16_t* base = O + ((size_t)(u.pm * (DFF / BK) + u.pn * 4 + (wc >> 1)) * (BM * BK)) + (size_t)((((wr * 4) * 2 + (wc & 1)) * 16 + fr) * 4 + fq) * 8;
#pragma unroll
        for (int ai = 0; ai < 2; ++ai)
#pragma unroll
            for (int m = 0; m < 4; ++m)
#pragma unroll
                for (int bj = 0; bj < 2; ++bj) { f32x4 v0 = acc[ai][bj][m][0], v1 = acc[ai][bj][m][1];
#pragma unroll
                    for (int i = 0; i < 4; ++i) { const float a = fmaxf(v0[i], 0.f), b = fmaxf(v1[i], 0.f); v0[i] = a * a; v1[i] = b * b; }
                    *(u32x4*)(base + (size_t)(2 * bj) * (BM * BK) + (size_t)((ai * 8 + m) * 2 * 4 * 16) * 8) = pack8(v0, v1); }
    }
};
constexpr int NSPLIT = 8, SAMPLE_ARRIVALS = (4 + 4 * NSPLIT) * 8;
__device__ __forceinline__ size_t tiled_slot(int t, int wr, int wc, int fr, int fq) { return (size_t)t * 65536 + (size_t)(((wr * 4 + wc) * 64 + fq * 16 + fr) * 8); }
__device__ __forceinline__ void st16_sc1(void* p, const f32x4 v) { asm volatile("global_store_dwordx4 %0, %1, off sc1\n\ts_nop 1" :: "v"(p), "v"(v) : "memory"); }
__device__ __forceinline__ void st16_sc1(void* p, const u32x4 v) { asm volatile("global_store_dwordx4 %0, %1, off sc1\n\ts_nop 1" :: "v"(p), "v"(v) : "memory"); }
template <int MODE> struct EpiGated {
    static constexpr bool PERM = true, AFTER_DRAIN = false;
    bf16_t* MIX; const bf16_t* Gt; int goff; const bf16_t* GS; float* slab; unsigned* cnt; bf16_t* TT;
    __device__ __forceinline__ void operator()(const f32x4 (&acc)[2][2][4][2], const Unit& u, int wr, int wc, int fr, int fq) const {
        const int row0 = u.pm * BM + wr * 64 + fr, col0 = u.pn * BM + wc * 32 + 8 * fq;
        if (u.pm == 128) {
            int rl0 = wr * 64 + fr; asm volatile("" : "+v"(rl0));
            if (MODE == 0) {
#pragma unroll
                for (int m = 0; m < 4; ++m)
#pragma unroll
                    for (int bj = 0; bj < 2; ++bj) { f32x4 v0 = acc[0][bj][m][0], v1 = acc[0][bj][m][1];
                        const u32x4 gw = *(const u32x4*)(GS + (size_t)(rl0 + m * 16) * DIN + goff + col0 + bj * HALF);
                        v0[0] *= bf_lo(gw.x); v0[1] *= bf_hi(gw.x); v0[2] *= bf_lo(gw.y); v0[3] *= bf_hi(gw.y);
                        v1[0] *= bf_lo(gw.z); v1[1] *= bf_hi(gw.z); v1[2] *= bf_lo(gw.w); v1[3] *= bf_hi(gw.w);
                        st16_sc1(MIX + (size_t)(MP + rl0 + m * 16) * DM + col0 + bj * HALF, pack8(v0, v1)); }
            } else {
                float* S = slab + (size_t)(u.kofs / (u.nk * BK)) * 256 * DM + (size_t)rl0 * DM + col0;
#pragma unroll
                for (int m = 0; m < 4; ++m)
#pragma unroll
                    for (int bj = 0; bj < 2; ++bj) { st16_sc1(S + (size_t)(m * 16) * DM + bj * HALF, acc[0][bj][m][0]); st16_sc1(S + (size_t)(m * 16) * DM + bj * HALF + 4, acc[0][bj][m][1]); }
            }
            asm volatile("s_waitcnt vmcnt(0)" ::: "memory");
            if ((threadIdx.x & 63) == 0) (void)__hip_atomic_fetch_add(cnt, 1u, __ATOMIC_RELAXED, __HIP_MEMORY_SCOPE_AGENT);
            return;
        }
        const bf16_t* gp = Gt + tiled_slot(u.pm * 8 + (MODE == 0 ? 4 : 0) + u.pn, wr, wc, fr, fq); bf16_t* tp = TT + tiled_slot(u.pm * 4 + u.pn, wr, wc, fr, fq);
#pragma unroll
        for (int ai = 0; ai < 2; ++ai)
#pragma unroll
            for (int m = 0; m < 4; ++m) { const size_t row = (size_t)(row0 + ai * HALF + m * 16);
#pragma unroll
                for (int bj = 0; bj < 2; ++bj) { f32x4 v0 = acc[ai][bj][m][0], v1 = acc[ai][bj][m][1]; const int sl = ((ai * 4 + m) * 2 + bj) * 4096;
                    const u32x4 gw = *(const u32x4*)(gp + sl);
                    v0[0] *= bf_lo(gw.x); v0[1] *= bf_hi(gw.x); v0[2] *= bf_lo(gw.y); v0[3] *= bf_hi(gw.y);
                    v1[0] *= bf_lo(gw.z); v1[1] *= bf_hi(gw.z); v1[2] *= bf_lo(gw.w); v1[3] *= bf_hi(gw.w);
                    if (MODE == 0) *(u32x4*)(tp + sl) = pack8(v0, v1);
                    else { const u32x4 t = *(const u32x4*)(tp + sl);
                        v0[0] += bf_lo(t.x); v0[1] += bf_hi(t.x); v0[2] += bf_lo(t.y); v0[3] += bf_hi(t.y);
                        v1[0] += bf_lo(t.z); v1[1] += bf_hi(t.z); v1[2] += bf_lo(t.w); v1[3] += bf_hi(t.w);
                        *(u32x4*)(MIX + row * DM + col0 + bj * HALF) = pack8(v0, v1); } } }
    }
};
struct EpiGateT {
    static constexpr bool PERM = true, AFTER_DRAIN = false;
    bf16_t* G;
    __device__ __forceinline__ void operator()(const f32x4 (&acc)[2][2][4][2], const Unit& u, int wr, int wc, int fr, int fq) const {
        bf16_t* gp = G + tiled_slot(u.pm * 8 + u.pn, wr, wc, fr, fq);
#pragma unroll
        for (int ai = 0; ai < 2; ++ai)
#pragma unroll
            for (int m = 0; m < 4; ++m)
#pragma unroll
                for (int bj = 0; bj < 2; ++bj) { f32x4 v0 = acc[ai][bj][m][0], v1 = acc[ai][bj][m][1];
#pragma unroll
                    for (int i = 0; i < 4; ++i) { v0[i] = sigmoid_f(v0[i]); v1[i] = sigmoid_f(v1[i]); }
                    *(u32x4*)(gp + ((ai * 4 + m) * 2 + bj) * 4096) = pack8(v0, v1); }
    }
};
struct EpiBf16S {
    static constexpr bool PERM = true, AFTER_DRAIN = false;
    bf16_t* O; int ldc; float* slab;
    __device__ __forceinline__ void operator()(const f32x4 (&acc)[2][2][4][2], const Unit& u, int wr, int wc, int fr, int fq) const {
        if (u.nk) {
            float* S = slab + (size_t)(u.kofs / (u.nk * BK)) * 256 * ldc + (size_t)(wr * 64 + fr) * ldc + u.pn * BM + wc * 32 + 8 * fq;
#pragma unroll
            for (int m = 0; m < 4; ++m)
#pragma unroll
                for (int bj = 0; bj < 2; ++bj) { *(f32x4*)(S + (size_t)(m * 16) * ldc + bj * HALF) = acc[0][bj][m][0]; *(f32x4*)(S + (size_t)(m * 16) * ldc + bj * HALF + 4) = acc[0][bj][m][1]; }
            return; }
        const int row0 = u.pm * BM + wr * 64 + fr, col0 = u.pn * BM + wc * 32 + 8 * fq;
#pragma unroll
        for (int ai = 0; ai < 2; ++ai)
#pragma unroll
            for (int m = 0; m < 4; ++m) { bf16_t* rowp = O + (size_t)(row0 + ai * HALF + m * 16) * ldc + col0;
#pragma unroll
                for (int bj = 0; bj < 2; ++bj) *(u32x4*)(rowp + bj * HALF) = pack8(acc[ai][bj][m][0], acc[ai][bj][m][1]); }
    }
};
struct EpiF32 {
    static constexpr bool PERM = false, AFTER_DRAIN = false;
    float* C; int ldc; float* slab;
    __device__ __forceinline__ void operator()(const f32x4 (&acc)[2][2][4][2], const Unit& u, int wr, int wc, int fr, int fq) const {
        if (u.nk) {
            float* S = slab + (size_t)(u.kofs / (u.nk * BK)) * 256 * ldc + (size_t)(wr * 64 + fr) * ldc + u.pn * BM + wc * 32 + 4 * fq;
#pragma unroll
            for (int m = 0; m < 4; ++m)
#pragma unroll
                for (int bj = 0; bj < 2; ++bj)
#pragma unroll
                    for (int n = 0; n < 2; ++n) *(f32x4*)(S + (size_t)(m * 16) * ldc + bj * HALF + n * 16) = acc[0][bj][m][n];
            return; }
        const int row0 = u.pm * BM + wr * 64 + fr, col0 = u.pn * BM + wc * 32 + 4 * fq;
#pragma unroll
        for (int ai = 0; ai < 2; ++ai)
#pragma unroll
            for (int m = 0; m < 4; ++m) { float* rowp = C + (size_t)(row0 + ai * HALF + m * 16) * ldc + col0;
#pragma unroll
                for (int bj = 0; bj < 2; ++bj)
#pragma unroll
                    for (int n = 0; n < 2; ++n) *(f32x4*)(rowp + bj * HALF + n * 16) = acc[ai][bj][m][n]; }
    }
};

template <class Epi, class Sched, bool ALIGN_EPI, bool ATILED = false>
__device__ __forceinline__ void gemm_phase(PG8_LAS unsigned char* lds, const Gemm g, const Sched& S, const Epi& E) {
    const int tid = threadIdx.x, wid = __builtin_amdgcn_readfirstlane(tid >> 6), lane = tid & 63, wr = wid >> 2, wc = wid & 3, fr = lane & 15, fq = lane >> 4;
    const int K = g.K;
    unsigned voffA[2], voffB[2];
#pragma unroll
    for (int i = 0; i < 2; ++i) { int R, C; stage_rc(tid * 16 + i * 8192, R, C); const int Rb = Epi::PERM ? ((R & ~31) + perm32(R & 31)) : R;
        voffA[i] = ATILED ? (unsigned)(tile_vec(R, C) * 16) : (unsigned)(R * g.lda + C) * 2u; voffB[i] = (unsigned)(tile_vec(R, C) * 16); (void)Rb; }
    const size_t kstep = (size_t)(BM * BK * 2)  , kstepA = ATILED ? (size_t)(BM * BK * 2) : (size_t)(BK * 2);
    const size_t hstepA = ATILED ? (size_t)(HALF * BK * 2) : (size_t)HALF * g.lda * 2, hstepB = (size_t)(HALF * BK * 2);
    const size_t tstepA = ATILED ? (size_t)(g.K / BK) * (size_t)(BM * BK * 2) : 2 * hstepA, tstepB = (size_t)(g.ldb / BK) * (size_t)(BM * BK * 2), pnA = (size_t)g.a_pn_off * 2;
#define PG8_KOFSB(u) ((size_t)((u).kofs / BK) * (size_t)(BM * BK * 2))
#define PG8_KOFSA(u) (ATILED ? (size_t)((u).kofs / BK) * (size_t)(BM * BK * 2) : (size_t)(u).kofs * 2)
    const unsigned ldsw = (unsigned)wid * 1024u;
    const int aoff = lds_byte(wr * 64 + fr, fq * 8), boff = lds_byte(wc * 32 + fr, fq * 8);
#define PG8_SA(b, h) (((b) * 2 + (h)) * HTB)
#define PG8_SB(b, h) ((4 + (b) * 2 + (h)) * HTB)
#define PG8_STAGE(bufoff, gbase, voff) do { _Pragma("unroll") for (int _i = 0; _i < 2; ++_i) \
        __builtin_amdgcn_global_load_lds((const unsigned*)((const char*)(gbase) + (voff)[_i]), (PG8_LAS unsigned*)(lds + (bufoff) + ldsw + _i * 8192), 16, 0, 0); } while (0)
#define PG8_LDA(dst, b, h) do { _Pragma("unroll") for (int m = 0; m < 4; ++m) _Pragma("unroll") for (int k = 0; k < 2; ++k) dst[m][k] = *(const PG8_LAS bf16x8*)(lds + PG8_SA(b, h) + aoff + m * 2048 + k * 1024); } while (0)
#define PG8_LDB(dst, b, h) do { _Pragma("unroll") for (int n = 0; n < 2; ++n) _Pragma("unroll") for (int k = 0; k < 2; ++k) dst[n][k] = *(const PG8_LAS bf16x8*)(lds + PG8_SB(b, h) + boff + n * 2048 + k * 1024); } while (0)
#define PG8_MMA(ai, bj, At, Bt) do { __builtin_amdgcn_s_setprio(1); _Pragma("unroll") for (int m = 0; m < 4; ++m) _Pragma("unroll") for (int n = 0; n < 2; ++n) _Pragma("unroll") for (int k = 0; k < 2; ++k) \
        acc[ai][bj][m][n] = __builtin_amdgcn_mfma_f32_16x16x32_bf16(Bt[n][k], At[m][k], acc[ai][bj][m][n], 0, 0, 0); __builtin_amdgcn_s_setprio(0); } while (0)
#define PG8_WAIT_V(n) asm volatile("s_waitcnt vmcnt(" #n ")" ::: "memory")
#define PG8_WAIT_L(n) asm volatile("s_waitcnt lgkmcnt(" #n ")" ::: "memory")
#define PG8_BAR __builtin_amdgcn_s_barrier()
#define PG8_SCHED __builtin_amdgcn_sched_barrier(0)
    Unit cur, nxt; int ui = 0;
    if (!S.next(0, cur)) return;
    f32x4 acc[2][2][4][2];
#pragma unroll
    for (int a = 0; a < 2; ++a)
#pragma unroll
        for (int b = 0; b < 2; ++b)
#pragma unroll
            for (int m = 0; m < 4; ++m)
#pragma unroll
                for (int n = 0; n < 2; ++n) acc[a][b][m][n] = (f32x4){0.f, 0.f, 0.f, 0.f};
    bf16x8 At[4][2], B0[2][2], B1[2][2];
    const char* cA = (const char*)g.A + (size_t)cur.pm * tstepA + (size_t)cur.pn * pnA + PG8_KOFSA(cur); const char* cB = (const char*)g.Bt + (size_t)cur.pn * tstepB + PG8_KOFSB(cur);
    PG8_STAGE(PG8_SB(0, 0), cB, voffB); PG8_STAGE(PG8_SB(0, 1), cB + hstepB, voffB); PG8_STAGE(PG8_SA(0, 0), cA, voffA); PG8_STAGE(PG8_SA(0, 1), cA + hstepA, voffA);
    if (wr == 1) PG8_BAR;
    PG8_WAIT_V(2); PG8_BAR;
    PG8_STAGE(PG8_SB(1, 0), cB + kstep, voffB); PG8_STAGE(PG8_SA(1, 0), cA + kstepA, voffA); PG8_STAGE(PG8_SB(1, 1), cB + hstepB + kstep, voffB);
    PG8_WAIT_V(6); PG8_BAR;
    for (;;) {
        const bool has_next = S.next(ui + 1, nxt);
        const bool half = unit_half(cur);
        const bool halfn = cur.hn != 0;
        const char* nA = has_next ? (const char*)g.A + (size_t)nxt.pm * tstepA + (size_t)nxt.pn * pnA + PG8_KOFSA(nxt) : cA; const char* nB = has_next ? (const char*)g.Bt + (size_t)nxt.pn * tstepB + PG8_KOFSB(nxt) : cB;
        const int nt = cur.nk ? cur.nk : K / BK;
        for (int t = 0; t < nt; t += 2) {
            const bool last = (t == nt - 2);
            const char* a1 = cA + (size_t)(t + 1) * kstepA;
            const char* a2 = last ? nA : cA + (size_t)(t + 2) * kstepA; const char* b2 = last ? nB : cB + (size_t)(t + 2) * kstep;
            const char* a3 = a2 + kstepA; const char* b3 = b2 + kstep;
            PG8_LDB(B0, 0, 0); PG8_LDB(B1, 0, 1); PG8_SCHED; PG8_LDA(At, 0, 0); PG8_STAGE(PG8_SA(1, 1), a1 + hstepA, voffA);
            PG8_WAIT_V(8); PG8_WAIT_L(0); PG8_BAR; PG8_MMA(0, 0, At, B0); if (!halfn) PG8_MMA(0, 1, At, B1); PG8_BAR; PG8_SCHED;
            if (!half) PG8_LDA(At, 0, 1); PG8_STAGE(PG8_SB(0, 0), b2, voffB); PG8_STAGE(PG8_SB(0, 1), b2 + hstepB, voffB); PG8_STAGE(PG8_SA(0, 0), a2, voffA);
            PG8_WAIT_V(8); PG8_WAIT_L(0); PG8_BAR; if (!half) { PG8_MMA(1, 0, At, B0); if (!halfn) PG8_MMA(1, 1, At, B1); } PG8_BAR; PG8_SCHED;
            PG8_LDB(B0, 1, 0); PG8_LDB(B1, 1, 1); PG8_SCHED; PG8_LDA(At, 1, 0); PG8_STAGE(PG8_SA(0, 1), a2 + hstepA, voffA);
            PG8_WAIT_V(8); PG8_WAIT_L(0); PG8_BAR; PG8_MMA(0, 0, At, B0); if (!halfn) PG8_MMA(0, 1, At, B1); PG8_BAR; PG8_SCHED;
            if (!half) PG8_LDA(At, 1, 1); PG8_STAGE(PG8_SB(1, 0), b3, voffB); PG8_STAGE(PG8_SB(1, 1), b3 + hstepB, voffB); PG8_STAGE(PG8_SA(1, 0), a3, voffA);
            PG8_WAIT_V(8); PG8_WAIT_L(0); PG8_BAR; if (!half) { PG8_MMA(1, 0, At, B0); if (!halfn) PG8_MMA(1, 1, At, B1); } PG8_BAR; PG8_SCHED;
        }
        if constexpr (ALIGN_EPI) { if (wr == 0) PG8_BAR; }
        E(acc, cur, wr, wc, fr, fq);
        if (!has_next) break;
#pragma unroll
        for (int a = 0; a < 2; ++a)
#pragma unroll
            for (int b = 0; b < 2; ++b)
#pragma unroll
                for (int m = 0; m < 4; ++m)
#pragma unroll
                    for (int n = 0; n < 2; ++n) acc[a][b][m][n] = (f32x4){0.f, 0.f, 0.f, 0.f};
        cur = nxt; cA = nA; cB = nB; ++ui;
        if constexpr (ALIGN_EPI) { if (wr == 1) PG8_BAR; }
    }
    PG8_WAIT_V(0);
    if constexpr (!ALIGN_EPI) { if (wr == 0) PG8_BAR; }
    PG8_BAR;
#undef PG8_SA
#undef PG8_KOFSA
#undef PG8_KOFSB
#undef PG8_SB
#undef PG8_STAGE
#undef PG8_LDA
#undef PG8_LDB
#undef PG8_MMA
#undef PG8_WAIT_V
#undef PG8_WAIT_L
#undef PG8_BAR
#undef PG8_SCHED
}
}

constexpr int NWAVES = 8;
constexpr size_t MiB = 1u << 20;
constexpr size_t WS_CTL = 0, CTL_ZERO_BYTES = 64 * 1024;
constexpr size_t WS_MOD = 1 * MiB;
constexpr size_t WS_WIN = 2 * MiB;
constexpr size_t WS_WSSD = 21 * MiB;
constexpr size_t WS_WPOOL = 25 * MiB;
constexpr size_t WS_WO = 26 * MiB;
constexpr size_t WS_WUP = 28 * MiB;
constexpr size_t WS_WDOWN = 36 * MiB;
constexpr size_t WS_DT = 44 * MiB;
constexpr size_t WS_HALO = 48 * MiB + 128 * 1024;
constexpr size_t WS_SSQ = 49 * MiB;
constexpr size_t WS_GS = 49 * MiB;
constexpr size_t WS_SLAB = 50 * MiB;
constexpr size_t WS_U = 58 * MiB;
constexpr size_t WS_Z = 123 * MiB;
constexpr size_t WS_XBC = 252 * MiB;
constexpr size_t WS_G = WS_XBC;
constexpr size_t WS_PM = WS_G + (size_t)MPAD * 2048 * 2;
constexpr size_t WS_MIXIN = WS_PM + (size_t)MPAD * 1024 * 2;
constexpr size_t WS_END = WS_XBC + (size_t)MPAD * 4096 * 2;
static_assert(WS_MIXIN + (size_t)MPAD * 1024 * 2 <= WS_END, "ws map");
static_assert(WS_U + (size_t)MPAD * 1024 * 2 <= WS_Z && WS_Z + (size_t)MPAD * 2048 * 2 <= WS_XBC && WS_SSQ + (size_t)MPAD * 64 * 4 <= WS_U && WS_DT + (size_t)MPAD * 32 * 4 <= WS_SSQ, "ws map");
constexpr int CW_BAR = 4096, CW_SCNT = 8192;

constexpr int RING_OFF = 0, RING_BYTES = 131072;
constexpr int LDSCTL_OFF = RING_BYTES, MISC_OFF = LDSCTL_OFF + 320;
constexpr int LDS_BYTES = 147456;

#define GAS __attribute__((address_space(1)))
#define LAS __attribute__((address_space(3)))
typedef unsigned short bf16;
typedef unsigned v4u __attribute__((ext_vector_type(4)));
typedef unsigned v2u __attribute__((ext_vector_type(2)));
typedef float f32x4 __attribute__((ext_vector_type(4)));
typedef short bf16x8 __attribute__((ext_vector_type(8)));
typedef GAS unsigned gu32;
#define RLX_AGENT __ATOMIC_RELAXED, __HIP_MEMORY_SCOPE_AGENT
#define LDS_WAIT() asm volatile("s_waitcnt lgkmcnt(0)" ::: "memory")
using pg8::cvt_pk_bf16; using pg8::bf_lo; using pg8::bf_hi; using pg8::silu_f;

#define XB_TMO      128
#define XB_XCNT(j)  (256  + 64 * (j))
#define XB_XSUB(j)  (1280 + 64 * (j))
#define XB_XGEN(j)  (2304 + 64 * (j))
#define XB_TOP      3328
#define XB_TOPGEN   3392
#define XCD_BAR_WORDS 3456
#define XB_SPIN_CAP (1u << 18)
__device__ __forceinline__ unsigned xb_ld(unsigned* p)              { return __hip_atomic_load(p, __ATOMIC_RELAXED, __HIP_MEMORY_SCOPE_AGENT); }
__device__ __forceinline__ unsigned xb_add(unsigned* p, unsigned v) { return __hip_atomic_fetch_add(p, v, __ATOMIC_RELAXED, __HIP_MEMORY_SCOPE_AGENT); }
__device__ __forceinline__ unsigned xb_xcc_id() { return (unsigned)__builtin_amdgcn_s_getreg((3 << 11) | 20) & 0xFu; }
#define XB_SPIN(cond, bar) do { unsigned _sp = 0; while (cond) { __builtin_amdgcn_s_sleep(1); \
    if ((++_sp & 255u) == 0u) { if (xb_ld(&(bar)[XB_TMO])) break; if (_sp > XB_SPIN_CAP) { atomicAdd(&(bar)[XB_TMO], 1u); break; } } } } while (0)
struct XcdBarrier { unsigned* bar; unsigned x; volatile LAS unsigned* st; };
__device__ __forceinline__ XcdBarrier xcd_barrier_post(unsigned* bar, volatile LAS unsigned* st) {
    XcdBarrier b; b.bar = bar; b.x = xb_xcc_id(); b.st = st;
    if (threadIdx.x == 0) (void)xb_add(&bar[XB_XCNT(b.x)], 1u);
    return b;
}
__device__ __forceinline__ void xcd_barrier_complete(unsigned* bar, unsigned x, unsigned& nloc, unsigned& nx) {
    const unsigned G = gridDim.x * gridDim.y * gridDim.z;
    unsigned sum, cnt, mine, sp = 0u;
    for (;;) {
        sum = 0u; cnt = 0u; mine = 0u;
#pragma unroll
        for (unsigned j = 0; j < 16; ++j) { const unsigned c = xb_ld(&bar[XB_XCNT(j)]); sum += c; cnt += (c > 0u) ? 1u : 0u; mine = (j == x) ? c : mine; }
        if (sum == G) break;
        __builtin_amdgcn_s_sleep(1);
        if ((++sp & 255u) == 0u) { if (xb_ld(&bar[XB_TMO])) break; if (sp > XB_SPIN_CAP) { atomicAdd(&bar[XB_TMO], 1u); break; } }
    }
    nloc = mine > 0u ? mine : 1u; nx = cnt > 0u ? cnt : 1u;
}
__device__ __forceinline__ void xcd_barrier(const XcdBarrier& b) {
    asm volatile("s_waitcnt vmcnt(0)" ::: "memory");
    __syncthreads();
    if (threadIdx.x == 0) {
        unsigned* bar = b.bar;
        __builtin_amdgcn_s_waitcnt(0);
        unsigned nloc = b.st[0], nx = b.st[1];
        if (nloc == 0u) { xcd_barrier_complete(bar, b.x, nloc, nx); b.st[0] = nloc; b.st[1] = nx; }
        const unsigned old = xb_add(&bar[XB_XSUB(b.x)], 1u);
        const unsigned gen = old / nloc;
        if (old + 1u == (gen + 1u) * nloc) {
            __builtin_amdgcn_fence(__ATOMIC_RELEASE, "agent");
            asm volatile("s_waitcnt vmcnt(0)" ::: "memory");
            const unsigned og = xb_add(&bar[XB_TOP], 1u);
            const unsigned tg = og / nx;
            if (og + 1u == (tg + 1u) * nx) xb_add(&bar[XB_TOPGEN], 1u);
            else XB_SPIN(xb_ld(&bar[XB_TOPGEN]) == tg, bar);
            xb_add(&bar[XB_XGEN(b.x)], 1u);
            __builtin_amdgcn_fence(__ATOMIC_ACQUIRE, "agent");
            asm volatile("s_waitcnt vmcnt(0)" ::: "memory");
        } else {
            XB_SPIN(xb_ld(&bar[XB_XGEN(b.x)]) == gen, bar);
            __builtin_amdgcn_fence(__ATOMIC_ACQUIRE, "agent");
            asm volatile("s_waitcnt vmcnt(0)" ::: "memory");
        }
    }
    __syncthreads();
}

struct Args { const float* in[26]; float* out; unsigned char* ws; int ph_lo, ph_hi; };
struct Frame {
    LAS unsigned char* lds;
    int tid, lane, wave, G, bid;
    const float* const* in; float* out; unsigned char* ws;
};
enum { I_XP = 0, I_XS, I_SSM, I_CONV, I_POOL, I_CP, I_CS, I_WADA, I_BADA, I_GPREMIX, I_GPOSTMIX, I_GPREMLP, I_GPOSTMLP, I_WIN, I_CONVW, I_CONVB, I_DTB, I_ALOG, I_DSKIP, I_GSSD,
       I_WSSD, I_WPOOL, I_PSCALE, I_WO, I_WUP, I_WDOWN };

__device__ __forceinline__ float wave_sum(float v) {
#pragma unroll
    for (int o = 1; o < 64; o <<= 1) v += __shfl_xor(v, o);
    return v;
}

__device__ __forceinline__ void p0_transpose_item(const float* W, int ldw, int c0, int k0, bf16* WT, int drow0, int ldk, const float* rs, const float* cs, LAS float* scr, int lane) {
    float tv[32];
#pragma unroll
    for (int i = 0; i < 32; ++i) tv[i] = W[(size_t)(k0 + 2 * i + (lane >> 5)) * ldw + c0 + (lane & 31)];
#pragma unroll
    for (int i = 0; i < 32; ++i) { const int kk = 2 * i + (lane >> 5); float v = tv[i];
        if (rs) v *= rs[k0 + kk]; if (cs) v *= cs[c0 + (lane & 31)]; scr[kk * 33 + (lane & 31)] = v; }
    LDS_WAIT(); asm volatile("" ::: "memory");
    const int c = lane & 7;
#pragma unroll
    for (int j = 0; j < 4; ++j) { const int n = (lane >> 3) + 8 * j; const LAS float* s = scr + (8 * c) * 33 + n;
        v4u o; o.x = cvt_pk_bf16(s[0 * 33], s[1 * 33]); o.y = cvt_pk_bf16(s[2 * 33], s[3 * 33]); o.z = cvt_pk_bf16(s[4 * 33], s[5 * 33]); o.w = cvt_pk_bf16(s[6 * 33], s[7 * 33]);
        const int nd = drow0 == 7168 ? 32 * (n >> 3) + 8 * ((n & 7) >> 1) + (n & 1) : n;
        { const int row = drow0 + nd, nl = row & 255, c32 = nl & 31, slot = (nl & ~31) + 16 * ((c32 >> 2) & 1) + 4 * (c32 >> 3) + (c32 & 3);
          *(GAS v4u*)(WT + ((size_t)((row >> 8) * (ldk / 64) + (k0 >> 6)) * 2048 + pg8::tile_vec(slot, 8 * c)) * 8) = o; } }
    LDS_WAIT(); asm volatile("" ::: "memory");
}
struct TSeg { const float* W; int ldw, c0, ncols, K; bf16* WT; int drow0; const float* rs; const float* cs; };
__device__ __forceinline__ bool p0_seg(const TSeg& s, int& r, LAS float* scr, int lane) {
    const int nblk = s.ncols / 32, items = (s.K / 64) * nblk;
    if (r < items) { const int kb = r / nblk, nb = r % nblk; p0_transpose_item(s.W, s.ldw, s.c0 + 32 * nb, 64 * kb, s.WT, s.drow0 + 32 * nb, s.K, s.rs, s.cs, scr, lane); return true; }
    r -= items; return false;
}
__device__ __forceinline__ void p0_prologue(Frame& F) {
    unsigned char* ws = F.ws;
    bf16* WinT = (bf16*)(ws + WS_WIN);
    const int gw = F.bid * NWAVES + F.wave, NGW = F.G * NWAVES;
    if (F.bid < 96) {
        LAS float* sl = (LAS float*)(F.lds);
        LAS float* red = (LAS float*)(F.lds + 65536);
        { float cv[32];
#pragma unroll
          for (int j = 0; j < 32; ++j) { const int r = j >> 1, k = F.tid + 512 * (j & 1); cv[j] = r < 8 ? F.in[I_CP][r * DM + k] : F.in[I_CS][(r - 8) * DM + k]; }
#pragma unroll
          for (int j = 0; j < 32; ++j) { const int r = j >> 1, k = F.tid + 512 * (j & 1); sl[k * 16 + r] = silu_f(cv[j]); } }
        __syncthreads();
        const int n0 = F.bid * 64; const float* wa = F.in[I_WADA] + n0 + F.lane;
        float acc[16];
#pragma unroll
        for (int r = 0; r < 16; ++r) acc[r] = 0.f;
        const int kb = F.wave * 128;
        for (int k0 = 0; k0 < 128; k0 += 32) {
            float wv[32];
#pragma unroll
            for (int i = 0; i < 32; ++i) wv[i] = wa[(size_t)(kb + k0 + i) * 6144];
#pragma unroll
            for (int i = 0; i < 32; ++i) { const LAS f32x4* sp = (const LAS f32x4*)(sl + (kb + k0 + i) * 16);
#pragma unroll
                for (int r4 = 0; r4 < 4; ++r4) { const f32x4 s = sp[r4]; acc[4 * r4 + 0] += s[0] * wv[i]; acc[4 * r4 + 1] += s[1] * wv[i]; acc[4 * r4 + 2] += s[2] * wv[i]; acc[4 * r4 + 3] += s[3] * wv[i]; } } }
#pragma unroll
        for (int r = 0; r < 16; ++r) red[(F.wave * 16 + r) * 64 + F.lane] = acc[r];
        __syncthreads();
        float* mod = (float*)(ws + WS_MOD);
        for (int i = F.tid; i < 16 * 64; i += NWAVES * 64) { const int r = i >> 6, c = i & 63; float s = F.in[I_BADA][n0 + c];
#pragma unroll
            for (int w = 0; w < 8; ++w) s += red[(w * 16 + r) * 64 + c];
            mod[r * 6144 + n0 + c] = s; }
        __syncthreads();
    }
    LAS float* scr = (LAS float*)(F.lds + RING_OFF + F.wave * 16384);
    const float* w_in = F.in[I_WIN];
    constexpr int NITEMS = 16 * (192 + 32 + 1 + 64) + 32 * 32 + 4 * 4 * 8 + 16 * 32 + 16 * 128 + 64 * 32;
#define P0_SEG(W, ldw, c0, ncols, K, WT, drow0, rs, cs) { const TSeg sg{W, ldw, c0, ncols, K, WT, drow0, rs, cs}; if (p0_seg(sg, r, scr, F.lane)) continue; }
    const int nmodw = (F.G > 96 ? 96 : F.G) * NWAVES, nslots = nmodw + 2 * (NGW - nmodw);
    for (int pass = 0; pass < 2; ++pass) {
      if (pass == 1 && gw < nmodw) break;
      const int slot = gw < nmodw ? gw : nmodw + pass * (NGW - nmodw) + (gw - nmodw);
      for (int it = slot; it < NITEMS; it += nslots) {
        int r = it;
        P0_SEG(w_in, 9248, 0, 6144, 1024, WinT, 0, nullptr, nullptr)
        P0_SEG(w_in, 9248, 6176, 1024, 1024, WinT, 6144, nullptr, nullptr)
        P0_SEG(w_in, 9248, 6144, 32, 1024, WinT, 7168, nullptr, nullptr)
        P0_SEG(w_in, 9248, 7200, 2048, 1024, WinT, 7424, nullptr, nullptr)
        P0_SEG(F.in[I_WSSD], 1024, 0, 1024, 2048, (bf16*)(ws + WS_WSSD), 0, F.in[I_GSSD], nullptr)
        P0_SEG(F.in[I_WPOOL] + 0 * 65536, 256, 0, 256, 256, (bf16*)(ws + WS_WPOOL), 0, nullptr, F.in[I_PSCALE] + 0)
        P0_SEG(F.in[I_WPOOL] + 1 * 65536, 256, 0, 256, 256, (bf16*)(ws + WS_WPOOL), 256, nullptr, F.in[I_PSCALE] + 256)
        P0_SEG(F.in[I_WPOOL] + 2 * 65536, 256, 0, 256, 256, (bf16*)(ws + WS_WPOOL), 512, nullptr, F.in[I_PSCALE] + 512)
        P0_SEG(F.in[I_WPOOL] + 3 * 65536, 256, 0, 256, 256, (bf16*)(ws + WS_WPOOL), 768, nullptr, F.in[I_PSCALE] + 768)
        P0_SEG(F.in[I_WO], 1024, 0, 1024, 1024, (bf16*)(ws + WS_WO), 0, nullptr, nullptr)
        P0_SEG(F.in[I_WUP], 4096, 0, 4096, 1024, (bf16*)(ws + WS_WUP), 0, nullptr, nullptr)
        P0_SEG(F.in[I_WDOWN], 1024, 0, 1024, 4096, (bf16*)(ws + WS_WDOWN), 0, nullptr, nullptr)
      }
    }
#undef P0_SEG
    { GAS v4u* z = (GAS v4u*)(WinT + (size_t)7168 * 1024); const int n16 = 256 * 1024 * 2 / 16;
      for (int i = F.bid * NWAVES * 64 + F.tid; i < n16; i += F.G * NWAVES * 64) { const int r = i >> 7, ch = i & 127, c32 = r & 31, slot = (r & ~31) + 16 * ((c32 >> 2) & 1) + 4 * (c32 >> 3) + (c32 & 3);
          if (!(r < 128 && (r & 7) < 2)) z[(ch >> 3) * 2048 + pg8::tile_vec(slot, 8 * (ch & 7))] = (v4u){0u, 0u, 0u, 0u}; } }
}

__device__ __forceinline__ const float* x_row(Frame& F, int m) { return m < MP ? F.in[I_XP] + (size_t)m * DM : F.in[I_XS] + (size_t)(m - MP) * DM; }
__device__ __forceinline__ int mod_row(int m) { return m < MP ? (m >> 12) : 8 + ((m - MP) >> 4); }
#define KCOL(j) (8 * lane + 512 * ((j) >> 1) + 4 * ((j) & 1))
#define FIDX(j) (2 * lane + 128 * ((j) >> 1) + ((j) & 1))
__device__ __forceinline__ void u_row(const f32x4 (&v)[4], const f32x4 (&gs)[4], const f32x4 (&sh)[4], bf16* urow, int lane) {
    float s2 = 0.f;
#pragma unroll
    for (int j = 0; j < 4; ++j) s2 += (v[j].x * v[j].x + v[j].y * v[j].y) + (v[j].z * v[j].z + v[j].w * v[j].w);
    const float rstd = rsqrtf(wave_sum(s2) * (1.f / DM) + EPS);
    GAS v4u* o16 = (GAS v4u*)urow + lane;
#pragma unroll
    for (int jp = 0; jp < 2; ++jp) { const f32x4 a = v[2 * jp] * rstd * gs[2 * jp] + sh[2 * jp], b = v[2 * jp + 1] * rstd * gs[2 * jp + 1] + sh[2 * jp + 1];
        o16[64 * jp] = (v4u){cvt_pk_bf16(a.x, a.y), cvt_pk_bf16(a.z, a.w), cvt_pk_bf16(b.x, b.y), cvt_pk_bf16(b.z, b.w)}; }
}
__device__ __forceinline__ void p1_u(Frame& F) {
    const int gw = F.bid * NWAVES + F.wave, NGW = F.G * NWAVES, lane = F.lane;
    const float* mod = (const float*)(F.ws + WS_MOD); bf16* U = (bf16*)(F.ws + WS_U);
    const float* gp = F.in[I_GPREMIX];
    for (int m = MP + (NGW - 1 - gw); m < MPAD; m += NGW) {
        if (m >= MR) { GAS v4u* o16 = (GAS v4u*)(U + (size_t)m * DM) + lane;
#pragma unroll
            for (int jp = 0; jp < 2; ++jp) o16[64 * jp] = (v4u){0u, 0u, 0u, 0u};
            continue; }
        const float* md = mod + mod_row(m) * 6144;
        f32x4 gs[4], sh[4], v[4];
        const GAS f32x4* xr = (const GAS f32x4*)x_row(F, m);
#pragma unroll
        for (int j = 0; j < 4; ++j) { const int k = KCOL(j); v[j] = xr[FIDX(j)]; gs[j] = *(const f32x4*)(gp + k) * (*(const f32x4*)(md + 1024 + k) + 1.0f); sh[j] = *(const f32x4*)(md + k); }
        u_row(v, gs, sh, U + (size_t)m * DM, lane);
    }
    for (int blk = gw; blk < MP / 16; blk += NGW) {
        const int m0 = blk * 16;
        const float* md = mod + mod_row(m0) * 6144;
        f32x4 gs[4], sh[4];
#pragma unroll
        for (int j = 0; j < 4; ++j) { const int k = KCOL(j); gs[j] = *(const f32x4*)(gp + k) * (*(const f32x4*)(md + 1024 + k) + 1.0f); sh[j] = *(const f32x4*)(md + k); }
        for (int r = 0; r < 16; r += 2) {
            f32x4 v0[4], v1[4];
            const GAS f32x4* x0 = (const GAS f32x4*)x_row(F, m0 + r); const GAS f32x4* x1 = (const GAS f32x4*)x_row(F, m0 + r + 1);
#pragma unroll
            for (int j = 0; j < 4; ++j) { v0[j] = x0[FIDX(j)]; v1[j] = x1[FIDX(j)]; }
            u_row(v0, gs, sh, U + (size_t)(m0 + r) * DM, lane); u_row(v1, gs, sh, U + (size_t)(m0 + r + 1) * DM, lane);
        }
    }
}

__device__ __forceinline__ void conv8_row(const float (&cw)[4][8], const float (&cb)[8], float (&win)[3][8], const v4u raw, v4u& outp) {
    float x[8] = {bf_lo(raw.x), bf_hi(raw.x), bf_lo(raw.y), bf_hi(raw.y), bf_lo(raw.z), bf_hi(raw.z), bf_lo(raw.w), bf_hi(raw.w)};
    float o[8];
#pragma unroll
    for (int e = 0; e < 8; ++e) { o[e] = silu_f(cb[e] + cw[0][e] * win[0][e] + cw[1][e] * win[1][e] + cw[2][e] * win[2][e] + cw[3][e] * x[e]); win[0][e] = win[1][e]; win[1][e] = win[2][e]; win[2][e] = x[e]; }
    outp = (v4u){cvt_pk_bf16(o[0], o[1]), cvt_pk_bf16(o[2], o[3]), cvt_pk_bf16(o[4], o[5]), cvt_pk_bf16(o[6], o[7])};
}
__device__ __forceinline__ void p2b_conv_bc(Frame& F) {
    bf16* XBC = (bf16*)(F.ws + WS_XBC); const bf16* HALO = (const bf16*)(F.ws + WS_HALO);
    const int tid = F.tid, cg = tid & 63, seg = tid >> 6;
    for (int item = F.bid; item < 256; item += F.G) {
        const int b = item >> 5, q = (item >> 3) & 3, rr = item & 7, col = 2048 + (q * 64 + cg) * 8;
        float cw[4][8], cb[8];
#pragma unroll
        for (int k = 0; k < 4; ++k) { const f32x4 a0 = *(const f32x4*)(F.in[I_CONVW] + k * CONVD + col), a1 = *(const f32x4*)(F.in[I_CONVW] + k * CONVD + col + 4);
            cw[k][0] = a0.x; cw[k][1] = a0.y; cw[k][2] = a0.z; cw[k][3] = a0.w; cw[k][4] = a1.x; cw[k][5] = a1.y; cw[k][6] = a1.z; cw[k][7] = a1.w; }
        { const f32x4 a0 = *(const f32x4*)(F.in[I_CONVB] + col), a1 = *(const f32x4*)(F.in[I_CONVB] + col + 4);
          cb[0] = a0.x; cb[1] = a0.y; cb[2] = a0.z; cb[3] = a0.w; cb[4] = a1.x; cb[5] = a1.y; cb[6] = a1.z; cb[7] = a1.w; }
        bf16* base = XBC + ((size_t)b * SEQ + (size_t)rr * 512 + (size_t)seg * 64) * CONVD + col;
        float win[3][8];
#pragma unroll
        for (int i = 0; i < 3; ++i) { v4u r = (v4u){0u, 0u, 0u, 0u};
            if (seg > 0) r = *(const GAS v4u*)(base - (size_t)(3 - i) * CONVD);
            else if (rr > 0) r = *(const GAS v4u*)(HALO + ((size_t)((b * 8 + rr) * 3 + i)) * 2048 + (col - 2048));
            win[i][0] = bf_lo(r.x); win[i][1] = bf_hi(r.x); win[i][2] = bf_lo(r.y); win[i][3] = bf_hi(r.y); win[i][4] = bf_lo(r.z); win[i][5] = bf_hi(r.z); win[i][6] = bf_lo(r.w); win[i][7] = bf_hi(r.w); }
        asm volatile("s_waitcnt vmcnt(0)" ::: "memory");
        __syncthreads();
        for (int blk = 0; blk < 8; ++blk) {
            v4u rw[8];
#pragma unroll
            for (int i = 0; i < 8; ++i) rw[i] = *(const GAS v4u*)(base + (size_t)(blk * 8 + i) * CONVD);
#pragma unroll
            for (int i = 0; i < 8; ++i) { v4u o; conv8_row(cw, cb, win, rw[i], o); *(GAS v4u*)(base + (size_t)(blk * 8 + i) * CONVD) = o; }
        }
        __syncthreads();
    }
}

constexpr int SS_CM = 0, SS_BM = 17408, SS_BWT = 34816, SS_XT = 53248, SS_XR = 71680, SS_GP = 90112, SS_HB = 108544, SS_SC = 125952, SS_PAR = 9216;
static_assert(SS_SC + 2 * 1280 <= RING_BYTES, "SSD LDS map");
constexpr int SS_XRAW = 132096;
static_assert(SS_XRAW >= MISC_OFF + 128 && SS_XRAW + 72 * 144 <= LDS_BYTES, "SSD raw image");
__device__ __forceinline__ bf16x8 ldfrag(LAS unsigned char* base, int row, int stride, int kbyte) { return *(const LAS bf16x8*)(base + row * stride + kbyte); }
__device__ __forceinline__ v4u pack8f(const float* f) { v4u o; o.x = cvt_pk_bf16(f[0], f[1]); o.y = cvt_pk_bf16(f[2], f[3]); o.z = cvt_pk_bf16(f[4], f[5]); o.w = cvt_pk_bf16(f[6], f[7]); return o; }

template <bool sample> __device__ __forceinline__ void ssd_unit(Frame& F, int b, int h) {
    LAS unsigned char* lds = F.lds;
    const int tid = F.tid, lane = F.lane, w = F.wave, r16 = lane & 15, q = lane >> 4;
    constexpr int CS = 64;
    const int g = h >> 2; constexpr int L = sample ? DSEQ : SEQ, nch = sample ? 1 : SEQ / CS, valid = sample ? DSEQ : CS;
    const size_t m0 = sample ? (size_t)(MP + b * DSEQ) : (size_t)b * SEQ;
    const float a = -__expf(F.in[I_ALOG][h]), Dh = F.in[I_DSKIP][h];
    const bf16* XBC = (const bf16*)(F.ws + WS_XBC); bf16* Zb = (bf16*)(F.ws + WS_Z);
    const float* DT = (const float*)(F.ws + WS_DT);
    const float* hist = F.in[I_CONV] + (size_t)b * 3 * CONVD;
    f32x4 acch[4];
#pragma unroll
    for (int pt = 0; pt < 4; ++pt) {
        if (sample) acch[pt] = *(const f32x4*)(F.in[I_SSM] + (((size_t)(b * NHEAD + h) * 64 + pt * 16 + r16) * 128 + w * 16 + 4 * q));
        else acch[pt] = (f32x4){0.f, 0.f, 0.f, 0.f}; }
    const int pp = tid & 31, xl0 = (tid >> 5) * 4, xcol = h * 64 + 2 * pp;
    float wk[4][2], bb[2];
#pragma unroll
    for (int k = 0; k < 4; ++k) { wk[k][0] = F.in[I_CONVW][k * CONVD + xcol]; wk[k][1] = F.in[I_CONVW][k * CONVD + xcol + 1]; }
    bb[0] = F.in[I_CONVB][xcol]; bb[1] = F.in[I_CONVB][xcol + 1];
    const bool isB = tid < 256; const int cg = tid & 15, bl0 = ((tid >> 4) & 15) * 4, bccol = (isB ? 2048 : 3072) + g * 128 + cg * 8;
    v4u bcraw[4], xr9[2];
    auto load_xraw = [&](int c) {
#pragma unroll
        for (int k = 0; k < 2; ++k) { const int i = k == 0 ? w : 8; const int r = 8 * i + (lane >> 3), t = c * CS - 3 + r, cc = h * 64 + (lane & 7) * 8;
            if (k == 1 && w != 0) break;
            if (r < 67 && t >= 0 && t < L) xr9[k] = *(const GAS v4u*)(XBC + (m0 + t) * CONVD + cc);
            else if (r < 67 && t < 0 && sample) { const float* hp = hist + (size_t)(3 + t) * CONVD + cc; const f32x4 a0 = *(const f32x4*)hp, a1 = *(const f32x4*)(hp + 4);
                xr9[k] = (v4u){cvt_pk_bf16(a0.x, a0.y), cvt_pk_bf16(a0.z, a0.w), cvt_pk_bf16(a1.x, a1.y), cvt_pk_bf16(a1.z, a1.w)}; }
            else xr9[k] = (v4u){0u, 0u, 0u, 0u}; }
    };
    auto write_xraw = [&]() {
        *(LAS v4u*)(lds + SS_XRAW + (8 * w + (lane >> 3)) * 144 + (lane & 7) * 16) = xr9[0];
        if (w == 0) *(LAS v4u*)(lds + SS_XRAW + (64 + (lane >> 3)) * 144 + (lane & 7) * 16) = xr9[1];
    };
    auto load_raw = [&](int c) {
#pragma unroll
        for (int i = 0; i < 4; ++i) { const int t = c * CS + bl0 + i;
            bcraw[i] = (!sample || bl0 + i < valid) ? *(const GAS v4u*)(XBC + (m0 + t) * CONVD + bccol) : (v4u){0u, 0u, 0u, 0u}; }
    };
    auto scalars = [&](int par, float dtl) {
        LAS float* sc = (LAS float*)(lds + SS_SC + par * 1280);
        float x = dtl * a;
#define SSD_DPP_ADD(ctrl, rmask) x += __builtin_bit_cast(float, __builtin_amdgcn_update_dpp(0, __builtin_bit_cast(int, x), ctrl, rmask, 0xf, true))
        SSD_DPP_ADD(0x111, 0xf); SSD_DPP_ADD(0x112, 0xf); SSD_DPP_ADD(0x114, 0xf); SSD_DPP_ADD(0x118, 0xf);
        SSD_DPP_ADD(0x142, 0xa); SSD_DPP_ADD(0x143, 0xc);
#undef SSD_DPP_ADD
        const float aend = __builtin_bit_cast(float, __builtin_amdgcn_readlane(__builtin_bit_cast(int, x), 63));
        sc[lane] = x; sc[64 + lane] = dtl; sc[128 + lane] = __expf(aend - x) * dtl; sc[192 + lane] = __expf(x); if (lane == 0) sc[256] = __expf(aend);
    };
    const int zlt = w & 3, zhh = w >> 2, zlrow = zlt * 16 + r16;
    v2u zraw[2];
    auto load_z = [&](int c) {
#pragma unroll
        for (int j = 0; j < 2; ++j) zraw[j] = (!sample || zlrow < valid) ? *(const GAS v2u*)(Zb + (m0 + (size_t)c * CS + zlrow) * DIN + h * 64 + (2 * zhh + j) * 16 + 4 * q) : (v2u){0u, 0u};
    };
    if constexpr (sample) {
        if (bl0 < valid) {
            float cw[4][8], cb[8], win[3][8];
#pragma unroll
            for (int k = 0; k < 4; ++k) { const f32x4 a0 = *(const f32x4*)(F.in[I_CONVW] + k * CONVD + bccol), a1 = *(const f32x4*)(F.in[I_CONVW] + k * CONVD + bccol + 4);
                cw[k][0] = a0.x; cw[k][1] = a0.y; cw[k][2] = a0.z; cw[k][3] = a0.w; cw[k][4] = a1.x; cw[k][5] = a1.y; cw[k][6] = a1.z; cw[k][7] = a1.w; }
            { const f32x4 a0 = *(const f32x4*)(F.in[I_CONVB] + bccol), a1 = *(const f32x4*)(F.in[I_CONVB] + bccol + 4);
              cb[0] = a0.x; cb[1] = a0.y; cb[2] = a0.z; cb[3] = a0.w; cb[4] = a1.x; cb[5] = a1.y; cb[6] = a1.z; cb[7] = a1.w; }
#pragma unroll
            for (int i = 0; i < 3; ++i) { const int t = bl0 - 3 + i; v4u r;
                if (t >= 0) r = *(const GAS v4u*)(XBC + (m0 + t) * CONVD + bccol);
                else { const float* hp = hist + (size_t)(3 + t) * CONVD + bccol; const f32x4 a0 = *(const f32x4*)hp, a1 = *(const f32x4*)(hp + 4);
                    r = (v4u){cvt_pk_bf16(a0.x, a0.y), cvt_pk_bf16(a0.z, a0.w), cvt_pk_bf16(a1.x, a1.y), cvt_pk_bf16(a1.z, a1.w)}; }
                win[i][0] = bf_lo(r.x); win[i][1] = bf_hi(r.x); win[i][2] = bf_lo(r.y); win[i][3] = bf_hi(r.y); win[i][4] = bf_lo(r.z); win[i][5] = bf_hi(r.z); win[i][6] = bf_lo(r.w); win[i][7] = bf_hi(r.w); }
#pragma unroll
            for (int i = 0; i < 4; ++i) { const v4u raw = *(const GAS v4u*)(XBC + (m0 + bl0 + i) * CONVD + bccol); conv8_row(cw, cb, win, raw, bcraw[i]); }
        } else {
#pragma unroll
            for (int i = 0; i < 4; ++i) bcraw[i] = (v4u){0u, 0u, 0u, 0u}; }
    } else load_raw(0);
    load_z(0);
    load_xraw(0); write_xraw(); if (nch > 1) load_xraw(1);
    float dtn = 0.f;
    if (w == 0) { scalars(0, (!sample || lane < valid) ? DT[(m0 + lane) * 32 + h] : 0.f); if (nch > 1) dtn = DT[(m0 + CS + lane) * 32 + h]; }
    __syncthreads();
    for (int c = 0; c < nch; ++c) {
        const int par = c & 1;
        LAS float* sc = (LAS float*)(lds + SS_SC + par * 1280);
        LAS unsigned char* XT = lds + SS_XT + par * SS_PAR; LAS unsigned char* XR = lds + SS_XR + par * SS_PAR; LAS unsigned char* GP = lds + SS_GP + par * SS_PAR;
        { float xin[7][2];
#pragma unroll
          for (int i = 0; i < 7; ++i) { const unsigned xu = *(const LAS unsigned*)(lds + SS_XRAW + (xl0 + i) * 144 + pp * 4); xin[i][0] = bf_lo(xu); xin[i][1] = bf_hi(xu); }
          float o[2][4];
#pragma unroll
          for (int i = 0; i < 4; ++i)
#pragma unroll
              for (int e = 0; e < 2; ++e) { const float v = bb[e] + wk[0][e] * xin[i][e] + wk[1][e] * xin[i + 1][e] + wk[2][e] * xin[i + 2][e] + wk[3][e] * xin[i + 3][e];
                  o[e][i] = (!sample || xl0 + i < valid) ? silu_f(v) : 0.f; }
#pragma unroll
          for (int e = 0; e < 2; ++e) *(LAS v2u*)(XT + (2 * pp + e) * 144 + xl0 * 2) = (v2u){cvt_pk_bf16(o[e][0], o[e][1]), cvt_pk_bf16(o[e][2], o[e][3])};
#pragma unroll
          for (int i = 0; i < 4; ++i) *(LAS unsigned*)(XR + (xl0 + i) * 144 + pp * 4) = cvt_pk_bf16(o[0][i], o[1][i]);
          if (isB) {
#pragma unroll
              for (int i = 0; i < 4; ++i) *(LAS v4u*)(lds + SS_BM + (bl0 + i) * 272 + cg * 16) = bcraw[i];
              const f32x4 wv = *(const LAS f32x4*)(sc + 128 + bl0);
              const int bwsw = (((bl0 >> 3) ^ (cg >> 1)) << 4) + ((bl0 >> 2) & 1) * 8;
#pragma unroll
              for (int e = 0; e < 4; ++e) {
                  const unsigned u0 = e == 0 ? bcraw[0].x : (e == 1 ? bcraw[0].y : (e == 2 ? bcraw[0].z : bcraw[0].w));
                  const unsigned u1 = e == 0 ? bcraw[1].x : (e == 1 ? bcraw[1].y : (e == 2 ? bcraw[1].z : bcraw[1].w));
                  const unsigned u2 = e == 0 ? bcraw[2].x : (e == 1 ? bcraw[2].y : (e == 2 ? bcraw[2].z : bcraw[2].w));
                  const unsigned u3 = e == 0 ? bcraw[3].x : (e == 1 ? bcraw[3].y : (e == 2 ? bcraw[3].z : bcraw[3].w));
                  *(LAS v2u*)(lds + SS_BWT + (cg * 8 + 2 * e) * 144 + bwsw) = (v2u){cvt_pk_bf16(bf_lo(u0) * wv[0], bf_lo(u1) * wv[1]), cvt_pk_bf16(bf_lo(u2) * wv[2], bf_lo(u3) * wv[3])};
                  *(LAS v2u*)(lds + SS_BWT + (cg * 8 + 2 * e + 1) * 144 + bwsw) = (v2u){cvt_pk_bf16(bf_hi(u0) * wv[0], bf_hi(u1) * wv[1]), cvt_pk_bf16(bf_hi(u2) * wv[2], bf_hi(u3) * wv[3])}; }
          } else {
#pragma unroll
              for (int i = 0; i < 4; ++i) *(LAS v4u*)(lds + SS_CM + (bl0 + i) * 272 + cg * 16) = bcraw[i];
          }
          if (c + 1 < nch) load_raw(c + 1);
        }
#pragma unroll
        for (int pt = 0; pt < 4; ++pt) *(LAS v2u*)(lds + SS_HB + (pt * 16 + r16) * 272 + (w * 16 + 4 * q) * 2) = (v2u){cvt_pk_bf16(acch[pt][0], acch[pt][1]), cvt_pk_bf16(acch[pt][2], acch[pt][3])};
        __syncthreads();
        if (w == 0 && c + 1 < nch) { scalars(par ^ 1, dtn); if (c + 2 < nch) dtn = DT[(m0 + (size_t)(c + 2) * CS + lane) * 32 + h]; }
        if (c + 1 < nch) { write_xraw(); if (c + 2 < nch) load_xraw(c + 2); }
        const int lt = w & 3, hh = w >> 2, lrow = lt * 16 + r16;
        const size_t mrow = m0 + (size_t)c * CS + lrow;
        const bool rowok = !sample || lrow < valid;
        bf16x8 cf[4];
#pragma unroll
        for (int ks = 0; ks < 4; ++ks) cf[ks] = ldfrag(lds + SS_CM, lrow, 272, ks * 64 + q * 16);
#pragma unroll
        for (int j = 0; j < 2; ++j) { const int st = 2 * hh + j; f32x4 d = (f32x4){0.f, 0.f, 0.f, 0.f};
#pragma unroll
            for (int ks = 0; ks < 4; ++ks) d = __builtin_amdgcn_mfma_f32_16x16x32_bf16(ldfrag(lds + SS_BM, st * 16 + r16, 272, ks * 64 + q * 16), cf[ks], d, 0, 0, 0);
            const int s0 = st * 16 + 4 * q; const float al = sc[lrow];
            const f32x4 as = *(const LAS f32x4*)(sc + s0), ds = *(const LAS f32x4*)(sc + 64 + s0);
            float gv[4];
#pragma unroll
            for (int r = 0; r < 4; ++r) gv[r] = (lrow >= s0 + r) ? d[r] * __expf(al - as[r]) * ds[r] : 0.f;
            *(LAS v2u*)(GP + lrow * 144 + s0 * 2) = (v2u){cvt_pk_bf16(gv[0], gv[1]), cvt_pk_bf16(gv[2], gv[3])}; }
        f32x4 yoff[2];
#pragma unroll
        for (int j = 0; j < 2; ++j) { const int pt = 2 * hh + j; f32x4 d = (f32x4){0.f, 0.f, 0.f, 0.f};
#pragma unroll
            for (int ks = 0; ks < 4; ++ks) d = __builtin_amdgcn_mfma_f32_16x16x32_bf16(ldfrag(lds + SS_HB, pt * 16 + r16, 272, ks * 64 + q * 16), cf[ks], d, 0, 0, 0);
            yoff[j] = d; }
        { const float dend = sc[256];
          bf16x8 wf[2];
#pragma unroll
          for (int ks = 0; ks < 2; ++ks) wf[ks] = ldfrag(lds + SS_BWT, w * 16 + r16, 144, ((ks * 4 + q) ^ w) * 16);
#pragma unroll
          for (int pt = 0; pt < 4; ++pt) { acch[pt] = acch[pt] * dend;
#pragma unroll
              for (int ks = 0; ks < 2; ++ks) acch[pt] = __builtin_amdgcn_mfma_f32_16x16x32_bf16(wf[ks], ldfrag(XT, pt * 16 + r16, 144, ks * 64 + q * 16), acch[pt], 0, 0, 0); } }
        __syncthreads();
        { bf16x8 gf[2];
#pragma unroll
          for (int ks = 0; ks < 2; ++ks) gf[ks] = ldfrag(GP, lrow, 144, ks * 64 + q * 16);
          const float el = sc[192 + lrow];
#pragma unroll
          for (int j = 0; j < 2; ++j) { const int pt = 2 * hh + j, p0 = pt * 16 + 4 * q; f32x4 d = (f32x4){0.f, 0.f, 0.f, 0.f};
#pragma unroll
              for (int ks = 0; ks < 2; ++ks) d = __builtin_amdgcn_mfma_f32_16x16x32_bf16(ldfrag(XT, pt * 16 + r16, 144, ks * 64 + q * 16), gf[ks], d, 0, 0, 0);
              const v2u xr = *(const LAS v2u*)(XR + lrow * 144 + p0 * 2);
              const float xv[4] = {bf_lo(xr.x), bf_hi(xr.x), bf_lo(xr.y), bf_hi(xr.y)};
              const float zv[4] = {bf_lo(zraw[j].x), bf_hi(zraw[j].x), bf_lo(zraw[j].y), bf_hi(zraw[j].y)};
              float yz[4];
#pragma unroll
              for (int r = 0; r < 4; ++r) yz[r] = (d[r] + el * yoff[j][r] + Dh * xv[r]) * zv[r];
              if (rowok) *(GAS v2u*)(Zb + mrow * DIN + h * 64 + p0) = (v2u){cvt_pk_bf16(yz[0], yz[1]), cvt_pk_bf16(yz[2], yz[3])}; }
          if (c + 1 < nch) load_z(c + 1); }
    }
    { float* so = F.out + (sample ? OFF_SSM_S : OFF_SSM_P) + (size_t)(b * NHEAD + h) * 64 * 128;
#pragma unroll
      for (int pt = 0; pt < 4; ++pt) *(f32x4*)(so + (size_t)(pt * 16 + r16) * 128 + w * 16 + 4 * q) = acch[pt]; }
    __syncthreads();
}
__device__ __forceinline__ void p3_ssd(Frame& F) {
    for (int u = F.bid; u < 256; u += F.G) ssd_unit<false>(F, u >> 5, u & 31);
    for (int u = F.bid; u < 256; u += F.G) ssd_unit<true>(F, u >> 5, u & 31);
}

__device__ __forceinline__ void p4_norm_pool(Frame& F) {
    const int gw = F.bid * NWAVES + F.wave, NGW = F.G * NWAVES, lane = F.lane;
    bf16* Zb = (bf16*)(F.ws + WS_Z);
    const bool bal = NGW == 2048; const bool heavy = bal && gw >= 2032;
    const int nbase = bal ? (heavy ? 3 : 16) : (MR - gw + NGW - 1) / NGW, nrows = nbase + ((bal && gw < 336) ? 1 : 0);
    auto row_of = [&](int i) -> int { if (i < nbase) return gw + i * NGW; return gw < 208 ? 2032 + (gw & 15) + (3 + (gw >> 4)) * 2048 : MP + (gw - 208); };
    for (int i0 = 0; i0 < nrows; i0 += 2) {
        v4u vv[2][4]; int mrow[2];
#pragma unroll
        for (int r = 0; r < 2; ++r) { mrow[r] = i0 + r < nrows ? row_of(i0 + r) : -1;
            if (mrow[r] >= 0) { const GAS v4u* zr = (const GAS v4u*)(Zb + (size_t)mrow[r] * DIN) + lane;
#pragma unroll
                for (int j = 0; j < 4; ++j) vv[r][j] = zr[64 * j]; } }
#pragma unroll
        for (int r = 0; r < 2; ++r) { const int m = mrow[r]; if (m < 0) continue;
            GAS v4u* zr = (GAS v4u*)(Zb + (size_t)m * DIN) + lane;
#pragma unroll
            for (int j = 0; j < 4; ++j) { const v4u v = vv[r][j];
                float a = bf_lo(v.x) * bf_lo(v.x) + bf_hi(v.x) * bf_hi(v.x) + bf_lo(v.y) * bf_lo(v.y) + bf_hi(v.y) * bf_hi(v.y) + bf_lo(v.z) * bf_lo(v.z) + bf_hi(v.z) * bf_hi(v.z) + bf_lo(v.w) * bf_lo(v.w) + bf_hi(v.w) * bf_hi(v.w);
#pragma unroll
                for (int o = 1; o < 32; o <<= 1) a += __shfl_xor(a, o);
                const float rr = rsqrtf(a * (1.f / 256.f) + EPS);
                v4u w;
                w.x = cvt_pk_bf16(bf_lo(v.x) * rr, bf_hi(v.x) * rr); w.y = cvt_pk_bf16(bf_lo(v.y) * rr, bf_hi(v.y) * rr);
                w.z = cvt_pk_bf16(bf_lo(v.z) * rr, bf_hi(v.z) * rr); w.w = cvt_pk_bf16(bf_lo(v.w) * rr, bf_hi(v.w) * rr);
                zr[64 * j] = w; } }
    }
    const bf16* P = (const bf16*)F.out; bf16* PM = (bf16*)(F.ws + WS_PM);
    const int gt = F.bid * (NWAVES * 64) + F.tid, NGT = F.G * NWAVES * 64;
    for (int it = 0; ; ++it) {
        int idx;
        if (NGT == 131072) { if (it == 0) idx = gt; else if (it == 1 && gt >= 131072 - 1024) idx = 131072 + (gt - (131072 - 1024)); else break; }
        else { idx = gt + it * NGT; if (idx >= 131072 + 1024) break; }
        const bool sample = idx >= 131072; const int id = sample ? idx - 131072 : idx;
        const int cgp = id & 127, b = sample ? (id >> 7) : (id >> 14), rbk = sample ? 0 : ((id >> 7) & 127);
        const int wl = 2 << (cgp >> 5), t0 = rbk * 32, nrow = sample ? DSEQ : 32;
        const size_t mb = sample ? (size_t)(MP + b * DSEQ) : (size_t)b * SEQ;
        const float* hp = F.in[I_POOL] + (size_t)b * 15 * DM + cgp * 8;
        auto ldp = [&](int t, bool on, float* f) {
            if (on && t >= 0) { const v4u v = *(const GAS v4u*)(P + (mb + t) * DM + cgp * 8);
                f[0] = bf_lo(v.x); f[1] = bf_hi(v.x); f[2] = bf_lo(v.y); f[3] = bf_hi(v.y); f[4] = bf_lo(v.z); f[5] = bf_hi(v.z); f[6] = bf_lo(v.w); f[7] = bf_hi(v.w); }
            else if (on && sample) { const float* q = hp + (size_t)(15 + t) * DM; const f32x4 a0 = *(const f32x4*)q, a1 = *(const f32x4*)(q + 4);
                f[0] = a0.x; f[1] = a0.y; f[2] = a0.z; f[3] = a0.w; f[4] = a1.x; f[5] = a1.y; f[6] = a1.z; f[7] = a1.w; }
            else {
#pragma unroll
                for (int e = 0; e < 8; ++e) f[e] = 0.f; }
        };
        float sum[8];
#pragma unroll
        for (int e = 0; e < 8; ++e) sum[e] = 0.f;
        { float h[15][8];
#pragma unroll
          for (int i = 1; i < 16; ++i) ldp(t0 - i, i < wl, h[i - 1]);
#pragma unroll
          for (int i = 0; i < 15; ++i)
#pragma unroll
              for (int e = 0; e < 8; ++e) sum[e] += h[i][e]; }
        for (int tb = t0; tb < t0 + nrow; tb += 8) {
            float cur[8][8], old[8][8];
#pragma unroll
            for (int i = 0; i < 8; ++i) { ldp(tb + i, true, cur[i]); ldp(tb + i - wl + 1, true, old[i]); }
#pragma unroll
            for (int i = 0; i < 8; ++i) { const int t = tb + i;
                const int cnt = sample ? wl : (t + 1 < wl ? t + 1 : wl); const float inv = 1.0f / (float)cnt;
                float o[8];
#pragma unroll
                for (int e = 0; e < 8; ++e) { sum[e] += cur[i][e]; o[e] = sum[e] * inv - cur[i][e]; sum[e] -= old[i][e]; }
                *(GAS v4u*)(PM + (mb + t) * DM + cgp * 8) = pack8f(o); }
        }
    }
}

__device__ __forceinline__ void post_row(const f32x4 (&v)[4], const f32x4 (&bs)[4], const f32x4 (&gg)[4], const f32x4 (&gs2)[4], const f32x4 (&sh2)[4], bool first,
                                         bf16* x1b, bf16* vrow, float* orow, int lane) {
    float s2 = 0.f;
#pragma unroll
    for (int j = 0; j < 4; ++j) s2 += (v[j].x * v[j].x + v[j].y * v[j].y) + (v[j].z * v[j].z + v[j].w * v[j].w);
    const float rstd = rsqrtf(wave_sum(s2) * (1.f / DM) + EPS);
    f32x4 x1[4]; float q2 = 0.f;
#pragma unroll
    for (int j = 0; j < 4; ++j) { x1[j] = bs[j] + gg[j] * (v[j] * rstd);
        q2 += (x1[j].x * x1[j].x + x1[j].y * x1[j].y) + (x1[j].z * x1[j].z + x1[j].w * x1[j].w); }
    if (first) {
        GAS v4u* xw = (GAS v4u*)x1b + lane;
#pragma unroll
        for (int jp = 0; jp < 2; ++jp) xw[64 * jp] = (v4u){cvt_pk_bf16(x1[2 * jp].x, x1[2 * jp].y), cvt_pk_bf16(x1[2 * jp].z, x1[2 * jp].w), cvt_pk_bf16(x1[2 * jp + 1].x, x1[2 * jp + 1].y), cvt_pk_bf16(x1[2 * jp + 1].z, x1[2 * jp + 1].w)};
        const float r2 = rsqrtf(wave_sum(q2) * (1.f / DM) + EPS);
        GAS v4u* o16 = (GAS v4u*)vrow + lane;
#pragma unroll
        for (int jp = 0; jp < 2; ++jp) { const f32x4 a = x1[2 * jp] * r2 * gs2[2 * jp] + sh2[2 * jp], b = x1[2 * jp + 1] * r2 * gs2[2 * jp + 1] + sh2[2 * jp + 1];
            o16[64 * jp] = (v4u){cvt_pk_bf16(a.x, a.y), cvt_pk_bf16(a.z, a.w), cvt_pk_bf16(b.x, b.y), cvt_pk_bf16(b.z, b.w)}; }
    } else {
        GAS f32x4* ow = (GAS f32x4*)orow;
#pragma unroll
        for (int j = 0; j < 4; ++j) ow[FIDX(j)] = x1[j];
    }
}
__device__ __forceinline__ void p_post(Frame& F, const bf16* S, bool first, const float* slab, int nsl) {
    const int gw = F.bid * NWAVES + F.wave, NGW = F.G * NWAVES, lane = F.lane;
    const float* mod = (const float*)(F.ws + WS_MOD); bf16* V = (bf16*)(F.ws + WS_U);
    bf16* X1B = (bf16*)(F.ws + WS_Z) + (size_t)MPAD * DM;
    const float* gpost = first ? F.in[I_GPOSTMIX] : F.in[I_GPOSTMLP]; const float* gpre = F.in[I_GPREMLP];
    for (int m = MP + (NGW - 1 - gw); m < MPAD; m += NGW) {
        if (m >= MR) { if (first) { GAS v4u* o16 = (GAS v4u*)(V + (size_t)m * DM) + lane;
#pragma unroll
                for (int jp = 0; jp < 2; ++jp) o16[64 * jp] = (v4u){0u, 0u, 0u, 0u}; }
            continue; }
        const float* md = mod + mod_row(m) * 6144;
        f32x4 gg[4], gs2[4], sh2[4], v[4], bs[4];
#pragma unroll
        for (int j = 0; j < 4; ++j) { const int k = KCOL(j);
            gg[j] = *(const f32x4*)(gpost + k) * *(const f32x4*)(md + (first ? 2048 : 5120) + k);
            if (first) { gs2[j] = *(const f32x4*)(gpre + k) * (*(const f32x4*)(md + 4096 + k) + 1.0f); sh2[j] = *(const f32x4*)(md + 3072 + k); }
            else { gs2[j] = (f32x4){0.f, 0.f, 0.f, 0.f}; sh2[j] = gs2[j]; }
            v[j] = (f32x4){0.f, 0.f, 0.f, 0.f}; }
        for (int ks = 0; ks < nsl; ++ks) { const GAS f32x4* pr = (const GAS f32x4*)(slab + ((size_t)ks * 256 + (m - MP)) * DM);
#pragma unroll
            for (int j = 0; j < 4; ++j) v[j] += pr[FIDX(j)]; }
        if (first) { const GAS f32x4* br = (const GAS f32x4*)x_row(F, m);
#pragma unroll
            for (int j = 0; j < 4; ++j) bs[j] = br[FIDX(j)]; }
        else { const GAS v4u* x1r = (const GAS v4u*)(X1B + (size_t)m * DM) + lane;
#pragma unroll
            for (int jp = 0; jp < 2; ++jp) { const v4u t = x1r[64 * jp]; bs[2 * jp] = (f32x4){bf_lo(t.x), bf_hi(t.x), bf_lo(t.y), bf_hi(t.y)}; bs[2 * jp + 1] = (f32x4){bf_lo(t.z), bf_hi(t.z), bf_lo(t.w), bf_hi(t.w)}; } }
        post_row(v, bs, gg, gs2, sh2, first, X1B + (size_t)m * DM, V + (size_t)m * DM, F.out + (size_t)m * DM, lane);
    }
    for (int blk = gw; blk < MP / 16; blk += NGW) {
        const int m0 = blk * 16;
        const float* md = mod + mod_row(m0) * 6144;
        f32x4 gg[4], gs2[4], sh2[4];
#pragma unroll
        for (int j = 0; j < 4; ++j) { const int k = KCOL(j);
            gg[j] = *(const f32x4*)(gpost + k) * *(const f32x4*)(md + (first ? 2048 : 5120) + k);
            if (first) { gs2[j] = *(const f32x4*)(gpre + k) * (*(const f32x4*)(md + 4096 + k) + 1.0f); sh2[j] = *(const f32x4*)(md + 3072 + k); }
            else { gs2[j] = (f32x4){0.f, 0.f, 0.f, 0.f}; sh2[j] = gs2[j]; } }
        for (int r = 0; r < 16; r += 2) {
            f32x4 v[2][4], bs[2][4];
#pragma unroll
            for (int q = 0; q < 2; ++q) { const int m = m0 + r + q;
                { const GAS v4u* sr = (const GAS v4u*)(S + (size_t)m * DM) + lane;
#pragma unroll
                    for (int jp = 0; jp < 2; ++jp) { const v4u t = sr[64 * jp]; v[q][2 * jp] = (f32x4){bf_lo(t.x), bf_hi(t.x), bf_lo(t.y), bf_hi(t.y)}; v[q][2 * jp + 1] = (f32x4){bf_lo(t.z), bf_hi(t.z), bf_lo(t.w), bf_hi(t.w)}; } }
                if (first) { const GAS f32x4* br = (const GAS f32x4*)x_row(F, m);
#pragma unroll
                    for (int j = 0; j < 4; ++j) bs[q][j] = br[FIDX(j)]; }
                else { const GAS v4u* x1r = (const GAS v4u*)(X1B + (size_t)m * DM) + lane;
#pragma unroll
                    for (int jp = 0; jp < 2; ++jp) { const v4u t = x1r[64 * jp]; bs[q][2 * jp] = (f32x4){bf_lo(t.x), bf_hi(t.x), bf_lo(t.y), bf_hi(t.y)}; bs[q][2 * jp + 1] = (f32x4){bf_lo(t.z), bf_hi(t.z), bf_lo(t.w), bf_hi(t.w)}; } } }
#pragma unroll
            for (int q = 0; q < 2; ++q) { const int m = m0 + r + q;
                post_row(v[q], bs[q], gg, gs2, sh2, first, X1B + (size_t)m * DM, V + (size_t)m * DM, F.out + (size_t)m * DM, lane); }
        }
    }
}

__device__ __forceinline__ void sample_mix_merge(const Frame& F, int j, pg8::bf16_t* MIX, const pg8::bf16_t* GS, const float* slab, unsigned* cnt) {
    if (F.tid == 0) {
        unsigned sp = 0; while (__hip_atomic_load(cnt, RLX_AGENT) < (unsigned)pg8::SAMPLE_ARRIVALS) { __builtin_amdgcn_s_sleep(2); if (++sp > (1u << 22)) break; }
        __builtin_amdgcn_fence(__ATOMIC_ACQUIRE, "agent");
        asm volatile("s_waitcnt vmcnt(0)" ::: "memory");
    }
    __syncthreads();
    const int row = 4 * j + (F.tid >> 7), col = (F.tid & 127) * 8;
    const float* S = slab + (size_t)row * DM + col;
    f32x4 v0 = (f32x4){0.f, 0.f, 0.f, 0.f}, v1 = v0;
#pragma unroll
    for (int k = 0; k < pg8::NSPLIT; ++k) { v0 += *(const f32x4*)(S + (size_t)k * 256 * DM); v1 += *(const f32x4*)(S + (size_t)k * 256 * DM + 4); }
    const v4u gw = *(const v4u*)(GS + (size_t)row * DIN + col);
    pg8::bf16_t* mp = MIX + (size_t)(MP + row) * DM + col; const v4u t = *(const v4u*)mp;
    v0[0] = v0[0] * bf_lo(gw.x) + bf_lo(t.x); v0[1] = v0[1] * bf_hi(gw.x) + bf_hi(t.x); v0[2] = v0[2] * bf_lo(gw.y) + bf_lo(t.y); v0[3] = v0[3] * bf_hi(gw.y) + bf_hi(t.y);
    v1[0] = v1[0] * bf_lo(gw.z) + bf_lo(t.z); v1[1] = v1[1] * bf_hi(gw.z) + bf_hi(t.z); v1[2] = v1[2] * bf_lo(gw.w) + bf_lo(t.w); v1[3] = v1[3] * bf_hi(gw.w) + bf_hi(t.w);
    *(v4u*)mp = (v4u){cvt_pk_bf16(v0[0], v0[1]), cvt_pk_bf16(v0[2], v0[3]), cvt_pk_bf16(v1[0], v1[1]), cvt_pk_bf16(v1[2], v1[3])};
}

constexpr int NPHASE = 14;
__global__ void __launch_bounds__(NWAVES * 64, 2) fwd_kernel(Args args) {
    extern __shared__ __attribute__((aligned(16))) unsigned char lds[];
    Frame F;
    F.lds = (LAS unsigned char*)lds;
    F.tid = threadIdx.x; F.lane = F.tid & 63; F.wave = __builtin_amdgcn_readfirstlane(F.tid >> 6);
    F.G = gridDim.x; F.bid = blockIdx.x;
    F.in = args.in; F.out = args.out; F.ws = args.ws;
    unsigned char* ws = args.ws;
    for (int u = F.tid; u < (LDS_BYTES - LDSCTL_OFF) / 4; u += NWAVES * 64) ((LAS unsigned*)(F.lds + LDSCTL_OFF))[u] = 0u;
    __syncthreads();
    const int lo = args.ph_lo, hi = args.ph_hi;
    const bool multi = (hi - lo) > 1;
    XcdBarrier bar; bar.bar = (unsigned*)(ws + WS_CTL) + CW_BAR; bar.x = 0; bar.st = nullptr;
    if (multi) bar = xcd_barrier_post((unsigned*)(ws + WS_CTL) + CW_BAR, (volatile LAS unsigned*)(F.lds + MISC_OFF) + 8);
#define IN(k) (lo <= (k) && (k) < hi)
#define SEAM(k) do { if (IN(k) && IN((k) + 1)) xcd_barrier(bar); } while (0)
    using namespace pg8;
    bf16_t* U = (bf16_t*)(ws + WS_U); bf16_t* Zb = (bf16_t*)(ws + WS_Z); bf16_t* XBC = (bf16_t*)(ws + WS_XBC); bf16_t* Pb = (bf16_t*)args.out;
    bf16_t* Gb = (bf16_t*)(ws + WS_G); bf16_t* PM = (bf16_t*)(ws + WS_PM); bf16_t* MIXIN = (bf16_t*)(ws + WS_MIXIN);
    float* MIXF = (float*)(ws + WS_Z); bf16_t* HDN = (bf16_t*)(ws + WS_XBC);
    bf16_t* WinT = (bf16_t*)(ws + WS_WIN);

    if (IN(0)) { p0_prologue(F); } SEAM(0);
    if (IN(1)) { p1_u(F); } SEAM(1);
    if (IN(2)) {
        Gemm g{U, WinT, MPAD, N1A, DM, DM, DM, 0}; InProjOrder S; S.init(F.G, F.bid);
        Epi1a E{Zb, XBC, Pb, (float*)(ws + WS_DT), F.in[I_DTB], args.out, (bf16_t*)(ws + WS_GS), (bf16_t*)(ws + WS_HALO)};
        gemm_phase<Epi1a, InProjOrder, true>(F.lds + RING_OFF, g, S, E);
    } SEAM(2);
    if (IN(3)) { p2b_conv_bc(F); } SEAM(3);
    if (IN(4)) { p3_ssd(F); } SEAM(4);
    if (IN(5)) { p4_norm_pool(F); }
    if (IN(6)) {
        Gemm g{U, WinT + (size_t)N1A * DM, MP, N1B, DM, DM, DM, 0}; StaticOrder S; S.init(MP, N1B, F.G, F.bid);
        EpiGateT E{Gb};
        gemm_phase<EpiGateT, StaticOrder, true>(F.lds + RING_OFF, g, S, E);
    } SEAM(6);
    if (IN(7)) {
        Gemm g{PM, (bf16_t*)(ws + WS_WPOOL), MPAD, DM, 256, DM, 256, 256}; StaticOrder S; S.init(MPAD, DM, F.G, F.bid);
        EpiGated<0> E{MIXIN, Gb, 1024, (const bf16_t*)(ws + WS_GS), (float*)(ws + WS_SLAB), (unsigned*)(ws + WS_CTL) + CW_SCNT, Pb};
        gemm_phase<EpiGated<0>, StaticOrder, true>(F.lds + RING_OFF, g, S, E);
    }
    if (IN(8)) {
        Gemm g{Zb, (bf16_t*)(ws + WS_WSSD), MPAD, DM, DIN, DIN, DIN, 0}; SplitOrder S; S.init(4, 4, NSPLIT, DIN / BK / NSPLIT, F.G, F.bid, 32);
        EpiGated<1> E{MIXIN, Gb, 0, (const bf16_t*)(ws + WS_GS), (float*)(ws + WS_SLAB), (unsigned*)(ws + WS_CTL) + CW_SCNT, Pb};
        gemm_phase<EpiGated<1>, SplitOrder, true>(F.lds + RING_OFF, g, S, E);
        if (F.bid >= 32 && F.bid < 64) sample_mix_merge(F, F.bid - 32, MIXIN, (const bf16_t*)(ws + WS_GS), (const float*)(ws + WS_SLAB), (unsigned*)(ws + WS_CTL) + CW_SCNT);
    } SEAM(8);
    if (IN(9)) {
        Gemm g{MIXIN, (bf16_t*)(ws + WS_WO), MPAD, DM, DM, DM, DM, 0}; SplitOrder S; S.init(4, 4, 4, 4, F.G, F.bid);
        EpiBf16S E{(bf16_t*)MIXF, DM, (float*)(ws + WS_SLAB)};
        gemm_phase<EpiBf16S, SplitOrder, true>(F.lds + RING_OFF, g, S, E);
    } SEAM(9);
    if (IN(10)) { p_post(F, (const bf16*)MIXF, true, (const float*)(ws + WS_SLAB), 4); } SEAM(10);
    if (IN(11)) {
        Gemm g{U, (bf16_t*)(ws + WS_WUP), MPAD, DFF, DM, DM, DM, 0}; StaticOrder S; S.init(MPAD, DFF, F.G, F.bid);
        EpiHdnT E{HDN};
        gemm_phase<EpiHdnT, StaticOrder, true>(F.lds + RING_OFF, g, S, E);
    } SEAM(11);
    if (IN(12)) {
        Gemm g{HDN, (bf16_t*)(ws + WS_WDOWN), MPAD, DM, DFF, DFF, DFF, 0}; SplitOrderRev S; S.init(4, 4, 8, 8, F.G, F.bid);
        EpiBf16S E{(bf16_t*)MIXF, DM, (float*)(ws + WS_SLAB)};
        gemm_phase<EpiBf16S, SplitOrderRev, true, true>(F.lds + RING_OFF, g, S, E);
    } SEAM(12);
    if (IN(13)) { p_post(F, (const bf16*)MIXF, false, (const float*)(ws + WS_SLAB), 8); }
#undef IN
#undef SEAM
}


#ifndef MK_PER_PHASE
#define MK_PER_PHASE 0
#endif
extern "C" void kernel_launch(void* const* d_in, const int* in_sizes, int n_in, void* d_out, int out_size, void* d_ws, size_t ws_size, hipStream_t stream) {
    static int grid = 0;
    if (grid == 0) {
        if (n_in != 26 || in_sizes[0] != MP * DM || out_size != 38322176 || ws_size < WS_END) {
            fprintf(stderr, "kernel_launch: unexpected shapes: n_in %d in0 %d out %d ws %zu (need %zu)\n", n_in, n_in > 0 ? in_sizes[0] : -1, out_size, ws_size, (size_t)WS_END); grid = -1; return; }
        int dev = 0, cus = 0, per_cu = 0;
        if (hipGetDevice(&dev) != hipSuccess || hipDeviceGetAttribute(&cus, hipDeviceAttributeMultiprocessorCount, dev) != hipSuccess) { grid = -1; return; }
        if (hipFuncSetAttribute((const void*)fwd_kernel, hipFuncAttributeMaxDynamicSharedMemorySize, LDS_BYTES) != hipSuccess) { fprintf(stderr, "kernel_launch: hipFuncSetAttribute failed\n"); grid = -1; return; }
        if (hipOccupancyMaxActiveBlocksPerMultiprocessor(&per_cu, (const void*)fwd_kernel, NWAVES * 64, LDS_BYTES) != hipSuccess || per_cu < 1) {
            fprintf(stderr, "kernel_launch: occupancy query reports %d blocks per CU\n", per_cu); }
        (void)hipGetLastError();
        grid = cus;
    }
    if (grid < 0) return;
    (void)hipMemsetAsync((char*)d_ws + WS_CTL, 0, CTL_ZERO_BYTES, stream);
    Args a{};
    for (int i = 0; i < 26; ++i) a.in[i] = (const float*)d_in[i];
    a.out = (float*)d_out; a.ws = (unsigned char*)d_ws;
#if MK_PER_PHASE
    for (int p = 0; p < NPHASE; ++p) { a.ph_lo = p; a.ph_hi = p + 1; hipLaunchKernelGGL(fwd_kernel, dim3(grid), dim3(NWAVES * 64), LDS_BYTES, stream, a); }
#else
    a.ph_lo = 0; a.ph_hi = NPHASE;
    hipLaunchKernelGGL(fwd_kernel, dim3(grid), dim3(NWAVES * 64), LDS_BYTES, stream, a);
#endif
}
```

```cpp
#include <hip/hip_runtime.h>
#include <cstdio>
#include <cstdint>

constexpr int DM = 1024, NBATCH = 8, SEQ = 4096, DSEQ = 16;
constexpr int MP = NBATCH * SEQ;
constexpr int MS = NBATCH * DSEQ;
constexpr int MR = MP + MS;
constexpr int MPAD = 33024;
constexpr int DIN = 2048, NHEAD = 32, DFF = 4096, CONVD = 4096;
constexpr int N1A = 7424, N1B = 2048;
constexpr float EPS = 1e-6f;
constexpr size_t OFF_SSM_P = 33685504, OFF_CONV_P = 35782656, OFF_POOL_P = 35880960, OFF_SSM_S = 36003840, OFF_CONV_S = 38100992, OFF_POOL_S = 38199296;

namespace pg8 {
#define PG8_LAS __attribute__((address_space(3)))
typedef unsigned short bf16_t;
typedef short bf16x8 __attribute__((ext_vector_type(8)));
typedef float f32x4 __attribute__((ext_vector_type(4)));
typedef unsigned u32x4 __attribute__((ext_vector_type(4)));
typedef unsigned u32x2 __attribute__((ext_vector_type(2)));
constexpr int BM = 256, BK = 64, HALF = 128, HTB = HALF * BK * 2, STAGE_BYTES = 8 * HTB, NXCD = 8, WGM = 8;

__host__ __device__ __forceinline__ int lds_byte(int r, int c) { const int st = (r >> 4) * 2 + (c >> 5), rr = r & 15, cc = c & 31, ob = rr * 64 + cc * 2; return st * 1024 + (ob ^ (((ob >> 9) & 1) << 5)); }
__host__ __device__ __forceinline__ void stage_rc(int b, int& R, int& C) { const int st = b / 1024, sb = b % 1024, swz = sb ^ (((sb >> 9) & 1) << 5); R = (st >> 1) * 16 + swz / 64; C = (st & 1) * 32 + (swz % 64) / 2; }
__host__ __device__ __forceinline__ int tile_vec(int R, int C) { return (((R >> 4) * 2 + (C >> 5)) * 16 + (R & 15)) * 4 + ((C >> 3) & 3); }
__host__ __device__ __forceinline__ int perm32(int rho) { const int n = rho >> 4, i = rho & 15; return 8 * (i >> 2) + 4 * n + (i & 3); }

struct Unit { int pm, pn, kofs, nk, hn; };
__host__ __device__ __forceinline__ bool unit_half(const Unit& u) { return u.pm == 128; }
struct Gemm { const bf16_t* A; const bf16_t* Bt; int M, N, K, lda, ldb, a_pn_off; };

struct StaticOrder {
    int nM, nN, nwg, G, c;
    __host__ __device__ void init(int M, int N, int G_, int c_) { nM = M / BM; nN = N / BM; nwg = nM * nN; G = G_; c = c_; }
    __host__ __device__ bool next(int i, Unit& u) const {
        const long L = (long)i * G + c; if (L >= nwg) return false;
        int wgid = (int)L; { const int q = nwg / NXCD, r = nwg % NXCD, xcd = wgid % NXCD, off = wgid / NXCD; wgid = (xcd < r ? xcd * (q + 1) : r * (q + 1) + (xcd - r) * q) + off; }
        const int nig = WGM * nN, gid = wgid / nig, fm = gid * WGM, gsz = (nM - fm) < WGM ? (nM - fm) : WGM;
        u.pm = fm + ((wgid % nig) % gsz); u.pn = (wgid % nig) / gsz; u.kofs = 0; u.nk = 0; u.hn = 0; return true;
    }
};
template <bool REV = false> struct SplitOrderT {
    StaticOrder P; int np, nNs, ksplit, nk, G, c, ofs;
    __host__ __device__ void init(int nNp, int nNs_, int ksplit_, int nk_, int G_, int c_, int ofs_ = 0) { P.init(MP, nNp * BM, G_, c_); np = P.nwg; nNs = nNs_; ksplit = ksplit_; nk = nk_; G = G_; c = c_; ofs = ofs_; }
    __host__ __device__ bool next(int i, Unit& u) const {
        const long L = (long)i * G + c;
        if (L < np) return P.next(REV ? np / G - 1 - i : i, u);
        const int idx = (int)(L - np) - ofs; if (idx < 0 || idx >= nNs * ksplit) return false;
        u.pm = 128; u.pn = idx % nNs; const int ks = idx / nNs; u.kofs = ks * nk * BK; u.nk = ksplit > 1 ? nk : 0; u.hn = 0; return true;
    }
};

typedef SplitOrderT<false> SplitOrder; typedef SplitOrderT<true> SplitOrderRev;
struct InProjOrder {
    StaticOrder P; int G, c;
    __host__ __device__ void init(int G_, int c_) { P.init(MP, 28 * BM, G_, c_); G = G_; c = c_; }
    __host__ __device__ bool next(int i, Unit& u) const {
        const long L = (long)i * G + c;
        if (L < P.nwg) return P.next(i, u);
        int idx = (int)(L - P.nwg); u.kofs = 0; u.nk = 0;
        if (idx < 128) { u.pm = idx; u.pn = 28; u.hn = 1; return true; }
        idx -= 128; if (idx >= 37) return false;
        u.pm = 128; u.pn = idx; u.hn = idx == 28 ? 1 : 0; return true;
    }
};

typedef __bf16 bf16x2_t __attribute__((ext_vector_type(2)));
typedef float f32x2_t __attribute__((ext_vector_type(2)));
__device__ __forceinline__ unsigned cvt_pk_bf16(float lo, float hi) { const f32x2_t v = {lo, hi}; const bf16x2_t b = __builtin_convertvector(v, bf16x2_t); return __builtin_bit_cast(unsigned, b); }
__device__ __forceinline__ float bf_lo(unsigned u) { return __uint_as_float(u << 16); }
__device__ __forceinline__ float bf_hi(unsigned u) { return __uint_as_float(u & 0xffff0000u); }
__device__ __forceinline__ float silu_f(float v) { return v * __builtin_amdgcn_rcpf(1.0f + __expf(-v)); }
__device__ __forceinline__ float sigmoid_f(float v) { return __builtin_amdgcn_rcpf(1.0f + __expf(-v)); }
__device__ __forceinline__ float softplus_f(float x) { const float e = __expf(x); return x > 20.f ? x : (e < 1e-4f ? e * (1.f - 0.5f * e) : __logf(1.f + e)); }
__device__ __forceinline__ u32x4 pack8(const f32x4 a, const f32x4 b) { u32x4 w; w.x = cvt_pk_bf16(a[0], a[1]); w.y = cvt_pk_bf16(a[2], a[3]); w.z = cvt_pk_bf16(b[0], b[1]); w.w = cvt_pk_bf16(b[2], b[3]); return w; }


struct Epi1a {
    static constexpr bool PERM = true, AFTER_DRAIN = false;
    bf16_t* Z; bf16_t* XBC; bf16_t* P; float* DT; const float* dt_bias; float* out; bf16_t* GS; bf16_t* HALO;
    __device__ __forceinline__ void operator()(const f32x4 (&acc)[2][2][4][2], const Unit& u, int wr, int wc, int fr, int fq) const {
        const int pn = u.pn, row0 = u.pm * BM + wr * 64 + fr, cl0 = wc * 32 + 8 * fq;
        if (pn >= 29) {
#pragma unroll
            for (int m = 0; m < 4; ++m) { const int rl = wr * 64 + fr + m * 16;
#pragma unroll
                for (int bj = 0; bj < 2; ++bj) { f32x4 v0 = acc[0][bj][m][0], v1 = acc[0][bj][m][1];
#pragma unroll
                    for (int i = 0; i < 4; ++i) { v0[i] = sigmoid_f(v0[i]); v1[i] = sigmoid_f(v1[i]); }
                    *(u32x4*)(GS + (size_t)rl * DIN + (pn - 29) * BM + bj * HALF + cl0) = pack8(v0, v1); } }
        } else if (pn < 8) {
#pragma unroll
            for (int ai = 0; ai < 2; ++ai)
#pragma unroll
                for (int m = 0; m < 4; ++m) { const int row = row0 + ai * HALF + m * 16;
#pragma unroll
                    for (int bj = 0; bj < 2; ++bj) { f32x4 v0 = acc[ai][bj][m][0], v1 = acc[ai][bj][m][1];
#pragma unroll
                        for (int i = 0; i < 4; ++i) { v0[i] = silu_f(v0[i]); v1[i] = silu_f(v1[i]); }
                        *(u32x4*)(Z + (size_t)row * DIN + pn * BM + bj * HALF + cl0) = pack8(v0, v1); } }
        } else if (pn < 24) {
#pragma unroll
            for (int ai = 0; ai < 2; ++ai)
#pragma unroll
                for (int m = 0; m < 4; ++m) { const int row = row0 + ai * HALF + m * 16;
                    long so = -1;
                    if (row < MP) { const int t = row & (SEQ - 1); if (t >= SEQ - 3) so = (long)OFF_CONV_P + ((long)(row >> 12) * 3 + (t - (SEQ - 3))) * CONVD; }
                    else if (row < MR) { const int rs = row - MP, t = rs & 15; if (t >= DSEQ - 3) so = (long)OFF_CONV_S + ((long)(rs >> 4) * 3 + (t - (DSEQ - 3))) * CONVD; }
                    long ho = -1;
                    if (pn >= 16 && row < MP) { const int t = row & (SEQ - 1); if ((t & 511) >= 509 && t < SEQ - 512) ho = ((long)((row >> 12) * 8 + (t >> 9) + 1) * 3 + ((t & 511) - 509)) * 2048 - 2048; }
#pragma unroll
                    for (int bj = 0; bj < 2; ++bj) { const f32x4 v0 = acc[ai][bj][m][0], v1 = acc[ai][bj][m][1]; const int col = (pn - 8) * BM + bj * HALF + cl0; const u32x4 pk = pack8(v0, v1);
                        *(u32x4*)(XBC + (size_t)row * CONVD + col) = pk;
                        if (ho >= 0) *(u32x4*)(HALO + ho + col) = pk;
                        if (so >= 0) { *(f32x4*)(out + so + col) = v0; *(f32x4*)(out + so + col + 4) = v1; } } }
        } else if (pn < 28) {
#pragma unroll
            for (int ai = 0; ai < 2; ++ai)
#pragma unroll
                for (int m = 0; m < 4; ++m) { const int row = row0 + ai * HALF + m * 16;
                    long so = -1;
                    if (row < MP) { const int t = row & (SEQ - 1); if (t >= SEQ - 15) so = (long)OFF_POOL_P + ((long)(row >> 12) * 15 + (t - (SEQ - 15))) * DM; }
                    else if (row < MR) { const int rs = row - MP, t = rs & 15; if (t >= 1) so = (long)OFF_POOL_S + ((long)(rs >> 4) * 15 + (t - 1)) * DM; }
#pragma unroll
                    for (int bj = 0; bj < 2; ++bj) { const f32x4 v0 = acc[ai][bj][m][0], v1 = acc[ai][bj][m][1]; const int col = (pn - 24) * BM + bj * HALF + cl0;
                        *(u32x4*)(P + (size_t)row * DM + col) = pack8(v0, v1);
                        if (so >= 0) { *(f32x4*)(out + so + col) = v0; *(f32x4*)(out + so + col + 4) = v1; } } }
        } else {
            const int dc = 8 * wc + 2 * fq; const float b0 = dt_bias[dc], b1 = dt_bias[dc + 1];
#pragma unroll
            for (int ai = 0; ai < 2; ++ai)
#pragma unroll
                for (int m = 0; m < 4; ++m) { const int row = row0 + ai * HALF + m * 16;
                    f32x2_t o; o.x = softplus_f(acc[ai][0][m][0][0] + b0); o.y = softplus_f(acc[ai][0][m][0][1] + b1);
                    *(f32x2_t*)(DT + (size_t)row * 32 + dc) = o; }
        }
    }
};
template <int ACT> struct EpiAct {
    static constexpr bool PERM = true, AFTER_DRAIN = false;
    bf16_t* O; int ldc;
    __device__ __forceinline__ void operator()(const f32x4 (&acc)[2][2][4][2], const Unit& u, int wr, int wc, int fr, int fq) const {
        const int row0 = u.pm * BM + wr * 64 + fr, col0 = u.pn * BM + wc * 32 + 8 * fq;
#pragma unroll
        for (int ai = 0; ai < 2; ++ai)
#pragma unroll
            for (int m = 0; m < 4; ++m) { bf16_t* rowp = O + (size_t)(row0 + ai * HALF + m * 16) * ldc + col0;
#pragma unroll
                for (int bj = 0; bj < 2; ++bj) { f32x4 v0 = acc[ai][bj][m][0], v1 = acc[ai][bj][m][1];
#pragma unroll
                    for (int i = 0; i < 4; ++i) {
                        if (ACT == 1) { v0[i] = sigmoid_f(v0[i]); v1[i] = sigmoid_f(v1[i]); }
                        if (ACT == 2) { const float a = fmaxf(v0[i], 0.f), b = fmaxf(v1[i], 0.f); v0[i] = a * a; v1[i] = b * b; } }
                    *(u32x4*)(rowp + bj * HALF) = pack8(v0, v1); } }
    }
};
struct EpiHdnT {
    static constexpr bool PERM = true, AFTER_DRAIN = false;
    bf16_t* O;
    __device__ __forceinline__ void operator()(const f32x4 (&acc)[2][2][4][2], const Unit& u, int wr, int wc, int fr, int fq) const {
        bf16_t* base = O + ((size_t)(u.pm * (DFF / BK) + u.pn * 4 + (wc >> 1)) * (BM * BK)) + (size_t)((((wr * 4) * 2 + (wc & 1)) * 16 + fr) * 4 + fq) * 8;
#pragma unroll
        for (int ai = 0; ai < 2; ++ai)
#pragma unroll
            for (int m = 0; m < 4; ++m)
#pragma unroll
                for (int bj = 0; bj < 2; ++bj) { f32x4 v0 = acc[ai][bj][m][0], v1 = acc[ai][bj][m][1];
#pragma unroll
                    for (int i = 0; i < 4; ++i) { const float a = fmaxf(v0[i], 0.f), b = fmaxf(v1[i], 0.f); v0[i] = a * a; v1[i] = b * b; }
                    *(u32x4*)(base + (size_t)(2 * bj) * (BM * BK) + (size_t)((ai * 8 + m) * 2 * 4 * 16) * 8) = pack8(v0, v1); }
    }
};
constexpr int NSPLIT = 8, SAMPLE_ARRIVALS = (4 + 4 * NSPLIT) * 8;
__device__ __forceinline__ size_t tiled_slot(int t, int wr, int wc, int fr, int fq) { return (size_t)t * 65536 + (size_t)(((wr * 4 + wc) * 64 + fq * 16 + fr) * 8); }
__device__ __forceinline__ void st16_sc1(void* p, const f32x4 v) { asm volatile("global_store_dwordx4 %0, %1, off sc1\n\ts_nop 1" :: "v"(p), "v"(v) : "memory"); }
__device__ __forceinline__ void st16_sc1(void* p, const u32x4 v) { asm volatile("global_store_dwordx4 %0, %1, off sc1\n\ts_nop 1" :: "v"(p), "v"(v) : "memory"); }
template <int MODE> struct EpiGated {
    static constexpr bool PERM = true, AFTER_DRAIN = false;
    bf16_t* MIX; const bf16_t* Gt; int goff; const bf16_t* GS; float* slab; unsigned* cnt; bf16_t* TT;
    __device__ __forceinline__ void operator()(const f32x4 (&acc)[2][2][4][2], const Unit& u, int wr, int wc, int fr, int fq) const {
        const int row0 = u.pm * BM + wr * 64 + fr, col0 = u.pn * BM + wc * 32 + 8 * fq;
        if (u.pm == 128) {
            int rl0 = wr * 64 + fr; asm volatile("" : "+v"(rl0));
            if (MODE == 0) {
#pragma unroll
                for (int m = 0; m < 4; ++m)
#pragma unroll
                    for (int bj = 0; bj < 2; ++bj) { f32x4 v0 = acc[0][bj][m][0], v1 = acc[0][bj][m][1];
                        const u32x4 gw = *(const u32x4*)(GS + (size_t)(rl0 + m * 16) * DIN + goff + col0 + bj * HALF);
                        v0[0] *= bf_lo(gw.x); v0[1] *= bf_hi(gw.x); v0[2] *= bf_lo(gw.y); v0[3] *= bf_hi(gw.y);
                        v1[0] *= bf_lo(gw.z); v1[1] *= bf_hi(gw.z); v1[2] *= bf_lo(gw.w); v1[3] *= bf_hi(gw.w);
                        st16_sc1(MIX + (size_t)(MP + rl0 + m * 16) * DM + col0 + bj * HALF, pack8(v0, v1)); }
            } else {
                float* S = slab + (size_t)(u.kofs / (u.nk * BK)) * 256 * DM + (size_t)rl0 * DM + col0;
#pragma unroll
                for (int m = 0; m < 4; ++m)
#pragma unroll
                    for (int bj = 0; bj < 2; ++bj) { st16_sc1(S + (size_t)(m * 16) * DM + bj * HALF, acc[0][bj][m][0]); st16_sc1(S + (size_t)(m * 16) * DM + bj * HALF + 4, acc[0][bj][m][1]); }
            }
            asm volatile("s_waitcnt vmcnt(0)" ::: "memory");
            if ((threadIdx.x & 63) == 0) (void)__hip_atomic_fetch_add(cnt, 1u, __ATOMIC_RELAXED, __HIP_MEMORY_SCOPE_AGENT);
            return;
        }
        const bf16_t* gp = Gt + tiled_slot(u.pm * 8 + (MODE == 0 ? 4 : 0) + u.pn, wr, wc, fr, fq); bf16_t* tp = TT + tiled_slot(u.pm * 4 + u.pn, wr, wc, fr, fq);
#pragma unroll
        for (int ai = 0; ai < 2; ++ai)
#pragma unroll
            for (int m = 0; m < 4; ++m) { const size_t row = (size_t)(row0 + ai * HALF + m * 16);
#pragma unroll
                for (int bj = 0; bj < 2; ++bj) { f32x4 v0 = acc[ai][bj][m][0], v1 = acc[ai][bj][m][1]; const int sl = ((ai * 4 + m) * 2 + bj) * 4096;
                    const u32x4 gw = *(const u32x4*)(gp + sl);
                    v0[0] *= bf_lo(gw.x); v0[1] *= bf_hi(gw.x); v0[2] *= bf_lo(gw.y); v0[3] *= bf_hi(gw.y);
                    v1[0] *= bf_lo(gw.z); v1[1] *= bf_hi(gw.z); v1[2] *= bf_lo(gw.w); v1[3] *= bf_hi(gw.w);
                    if (MODE == 0) *(u32x4*)(tp + sl) = pack8(v0, v1);
                    else { const u32x4 t = *(const u32x4*)(tp + sl);
                        v0[0] += bf_lo(t.x); v0[1] += bf_hi(t.x); v0[2] += bf_lo(t.y); v0[3] += bf_hi(t.y);
                        v1[0] += bf_lo(t.z); v1[1] += bf_hi(t.z); v1[2] += bf_lo(t.w); v1[3] += bf_hi(t.w);
                        *(u32x4*)(MIX + row * DM + col0 + bj * HALF) = pack8(v0, v1); } } }
    }
};
struct EpiGateT {
    static constexpr bool PERM = true, AFTER_DRAIN = false;
    bf16_t* G;
    __device__ __forceinline__ void operator()(const f32x4 (&acc)[2][2][4][2], const Unit& u, int wr, int wc, int fr, int fq) const {
        bf16_t* gp = G + tiled_slot(u.pm * 8 + u.pn, wr, wc, fr, fq);
#pragma unroll
        for (int ai = 0; ai < 2; ++ai)
#pragma unroll
            for (int m = 0; m < 4; ++m)
#pragma unroll
                for (int bj = 0; bj < 2; ++bj) { f32x4 v0 = acc[ai][bj][m][0], v1 = acc[ai][bj][m][1];
#pragma unroll
                    for (int i = 0; i < 4; ++i) { v0[i] = sigmoid_f(v0[i]); v1[i] = sigmoid_f(v1[i]); }
                    *(u32x4*)(gp + ((ai * 4 + m) * 2 + bj) * 4096) = pack8(v0, v1); }
    }
};
struct EpiBf16S {
    static constexpr bool PERM = true, AFTER_DRAIN = false;
    bf16_t* O; int ldc; float* slab;
    __device__ __forceinline__ void operator()(const f32x4 (&acc)[2][2][4][2], const Unit& u, int wr, int wc, int fr, int fq) const {
        if (u.nk) {
            float* S = slab + (size_t)(u.kofs / (u.nk * BK)) * 256 * ldc + (size_t)(wr * 64 + fr) * ldc + u.pn * BM + wc * 32 + 8 * fq;
#pragma unroll
            for (int m = 0; m < 4; ++m)
#pragma unroll
                for (int bj = 0; bj < 2; ++bj) { *(f32x4*)(S + (size_t)(m * 16) * ldc + bj * HALF) = acc[0][bj][m][0]; *(f32x4*)(S + (size_t)(m * 16) * ldc + bj * HALF + 4) = acc[0][bj][m][1]; }
            return; }
        const int row0 = u.pm * BM + wr * 64 + fr, col0 = u.pn * BM + wc * 32 + 8 * fq;
#pragma unroll
        for (int ai = 0; ai < 2; ++ai)
#pragma unroll
            for (int m = 0; m < 4; ++m) { bf16_t* rowp = O + (size_t)(row0 + ai * HALF + m * 16) * ldc + col0;
#pragma unroll
                for (int bj = 0; bj < 2; ++bj) *(u32x4*)(rowp + bj * HALF) = pack8(acc[ai][bj][m][0], acc[ai][bj][m][1]); }
    }
};
struct EpiF32 {
    static constexpr bool PERM = false, AFTER_DRAIN = false;
    float* C; int ldc; float* slab;
    __device__ __forceinline__ void operator()(const f32x4 (&acc)[2][2][4][2], const Unit& u, int wr, int wc, int fr, int fq) const {
        if (u.nk) {
            float* S = slab + (size_t)(u.kofs / (u.nk * BK)) * 256 * ldc + (size_t)(wr * 64 + fr) * ldc + u.pn * BM + wc * 32 + 4 * fq;
#pragma unroll
            for (int m = 0; m < 4; ++m)
#pragma unroll
                for (int bj = 0; bj < 2; ++bj)
#pragma unroll
                    for (int n = 0; n < 2; ++n) *(f32x4*)(S + (size_t)(m * 16) * ldc + bj * HALF + n * 16) = acc[0][bj][m][n];
            return; }
        const int row0 = u.pm * BM + wr * 64 + fr, col0 = u.pn * BM + wc * 32 + 4 * fq;
#pragma unroll
        for (int ai = 0; ai < 2; ++ai)
#pragma unroll
            for (int m = 0; m < 4; ++m) { float* rowp = C + (size_t)(row0 + ai * HALF + m * 16) * ldc + col0;
#pragma unroll
                for (int bj = 0; bj < 2; ++bj)
#pragma unroll
                    for (int n = 0; n < 2; ++n) *(f32x4*)(rowp + bj * HALF + n * 16) = acc[ai][bj][m][n]; }
    }
};

template <class Epi, class Sched, bool ALIGN_EPI, bool ATILED = false>
__device__ __forceinline__ void gemm_phase(PG8_LAS unsigned char* lds, const Gemm g, const Sched& S, const Epi& E) {
    const int tid = threadIdx.x, wid = __builtin_amdgcn_readfirstlane(tid >> 6), lane = tid & 63, wr = wid >> 2, wc = wid & 3, fr = lane & 15, fq = lane >> 4;
    const int K = g.K;
    unsigned voffA[2], voffB[2];
#pragma unroll
    for (int i = 0; i < 2; ++i) { int R, C; stage_rc(tid * 16 + i * 8192, R, C); const int Rb = Epi::PERM ? ((R & ~31) + perm32(R & 31)) : R;
        voffA[i] = ATILED ? (unsigned)(tile_vec(R, C) * 16) : (unsigned)(R * g.lda + C) * 2u; voffB[i] = (unsigned)(tile_vec(R, C) * 16); (void)Rb; }
    const size_t kstep = (size_t)(BM * BK * 2)  , kstepA = ATILED ? (size_t)(BM * BK * 2) : (size_t)(BK * 2);
    const size_t hstepA = ATILED ? (size_t)(HALF * BK * 2) : (size_t)HALF * g.lda * 2, hstepB = (size_t)(HALF * BK * 2);
    const size_t tstepA = ATILED ? (size_t)(g.K / BK) * (size_t)(BM * BK * 2) : 2 * hstepA, tstepB = (size_t)(g.ldb / BK) * (size_t)(BM * BK * 2), pnA = (size_t)g.a_pn_off * 2;
#define PG8_KOFSB(u) ((size_t)((u).kofs / BK) * (size_t)(BM * BK * 2))
#define PG8_KOFSA(u) (ATILED ? (size_t)((u).kofs / BK) * (size_t)(BM * BK * 2) : (size_t)(u).kofs * 2)
    const unsigned ldsw = (unsigned)wid * 1024u;
    const int aoff = lds_byte(wr * 64 + fr, fq * 8), boff = lds_byte(wc * 32 + fr, fq * 8);
#define PG8_SA(b, h) (((b) * 2 + (h)) * HTB)
#define PG8_SB(b, h) ((4 + (b) * 2 + (h)) * HTB)
#define PG8_STAGE(bufoff, gbase, voff) do { _Pragma("unroll") for (int _i = 0; _i < 2; ++_i) \
        __builtin_amdgcn_global_load_lds((const unsigned*)((const char*)(gbase) + (voff)[_i]), (PG8_LAS unsigned*)(lds + (bufoff) + ldsw + _i * 8192), 16, 0, 0); } while (0)
#define PG8_LDA(dst, b, h) do { _Pragma("unroll") for (int m = 0; m < 4; ++m) _Pragma("unroll") for (int k = 0; k < 2; ++k) dst[m][k] = *(const PG8_LAS bf16x8*)(lds + PG8_SA(b, h) + aoff + m * 2048 + k * 1024); } while (0)
#define PG8_LDB(dst, b, h) do { _Pragma("unroll") for (int n = 0; n < 2; ++n) _Pragma("unroll") for (int k = 0; k < 2; ++k) dst[n][k] = *(const PG8_LAS bf16x8*)(lds + PG8_SB(b, h) + boff + n * 2048 + k * 1024); } while (0)
#define PG8_MMA(ai, bj, At, Bt) do { __builtin_amdgcn_s_setprio(1); _Pragma("unroll") for (int m = 0; m < 4; ++m) _Pragma("unroll") for (int n = 0; n < 2; ++n) _Pragma("unroll") for (int k = 0; k < 2; ++k) \
        acc[ai][bj][m][n] = __builtin_amdgcn_mfma_f32_16x16x32_bf16(Bt[n][k], At[m][k], acc[ai][bj][m][n], 0, 0, 0); __builtin_amdgcn_s_setprio(0); } while (0)
#define PG8_WAIT_V(n) asm volatile("s_waitcnt vmcnt(" #n ")" ::: "memory")
#define PG8_WAIT_L(n) asm volatile("s_waitcnt lgkmcnt(" #n ")" ::: "memory")
#define PG8_BAR __builtin_amdgcn_s_barrier()
#define PG8_SCHED __builtin_amdgcn_sched_barrier(0)
    Unit cur, nxt; int ui = 0;
    if (!S.next(0, cur)) return;
    f32x4 acc[2][2][4][2];
#pragma unroll
    for (int a = 0; a < 2; ++a)
#pragma unroll
        for (int b = 0; b < 2; ++b)
#pragma unroll
            for (int m = 0; m < 4; ++m)
#pragma unroll
                for (int n = 0; n < 2; ++n) acc[a][b][m][n] = (f32x4){0.f, 0.f, 0.f, 0.f};
    bf16x8 At[4][2], B0[2][2], B1[2][2];
    const char* cA = (const char*)g.A + (size_t)cur.pm * tstepA + (size_t)cur.pn * pnA + PG8_KOFSA(cur); const char* cB = (const char*)g.Bt + (size_t)cur.pn * tstepB + PG8_KOFSB(cur);
    PG8_STAGE(PG8_SB(0, 0), cB, voffB); PG8_STAGE(PG8_SB(0, 1), cB + hstepB, voffB); PG8_STAGE(PG8_SA(0, 0), cA, voffA); PG8_STAGE(PG8_SA(0, 1), cA + hstepA, voffA);
    if (wr == 1) PG8_BAR;
    PG8_WAIT_V(2); PG8_BAR;
    PG8_STAGE(PG8_SB(1, 0), cB + kstep, voffB); PG8_STAGE(PG8_SA(1, 0), cA + kstepA, voffA); PG8_STAGE(PG8_SB(1, 1), cB + hstepB + kstep, voffB);
    PG8_WAIT_V(6); PG8_BAR;
    for (;;) {
        const bool has_next = S.next(ui + 1, nxt);
        const bool half = unit_half(cur);
        const bool halfn = cur.hn != 0;
        const char* nA = has_next ? (const char*)g.A + (size_t)nxt.pm * tstepA + (size_t)nxt.pn * pnA + PG8_KOFSA(nxt) : cA; const char* nB = has_next ? (const char*)g.Bt + (size_t)nxt.pn * tstepB + PG8_KOFSB(nxt) : cB;
        const int nt = cur.nk ? cur.nk : K / BK;
        for (int t = 0; t < nt; t += 2) {
            const bool last = (t == nt - 2);
            const char* a1 = cA + (size_t)(t + 1) * kstepA;
            const char* a2 = last ? nA : cA + (size_t)(t + 2) * kstepA; const char* b2 = last ? nB : cB + (size_t)(t + 2) * kstep;
            const char* a3 = a2 + kstepA; const char* b3 = b2 + kstep;
            PG8_LDB(B0, 0, 0); PG8_LDB(B1, 0, 1); PG8_SCHED; PG8_LDA(At, 0, 0); PG8_STAGE(PG8_SA(1, 1), a1 + hstepA, voffA);
            PG8_WAIT_V(8); PG8_WAIT_L(0); PG8_BAR; PG8_MMA(0, 0, At, B0); if (!halfn) PG8_MMA(0, 1, At, B1); PG8_BAR; PG8_SCHED;
            if (!half) PG8_LDA(At, 0, 1); PG8_STAGE(PG8_SB(0, 0), b2, voffB); PG8_STAGE(PG8_SB(0, 1), b2 + hstepB, voffB); PG8_STAGE(PG8_SA(0, 0), a2, voffA);
            PG8_WAIT_V(8); PG8_WAIT_L(0); PG8_BAR; if (!half) { PG8_MMA(1, 0, At, B0); if (!halfn) PG8_MMA(1, 1, At, B1); } PG8_BAR; PG8_SCHED;
            PG8_LDB(B0, 1, 0); PG8_LDB(B1, 1, 1); PG8_SCHED; PG8_LDA(At, 1, 0); PG8_STAGE(PG8_SA(0, 1), a2 + hstepA, voffA);
            PG8_WAIT_V(8); PG8_WAIT_L(0); PG8_BAR; PG8_MMA(0, 0, At, B0); if (!halfn) PG8_MMA(0, 1, At, B1); PG8_BAR; PG8_SCHED;
            if (!half) PG8_LDA(At, 1, 1); PG8_STAGE(PG8_SB(1, 0), b3, voffB); PG8_STAGE(PG8_SB(1, 1), b3 + hstepB, voffB); PG8_STAGE(PG8_SA(1, 0), a3, voffA);
            PG8_WAIT_V(8); PG8_WAIT_L(0); PG8_BAR; if (!half) { PG8_MMA(1, 0, At, B0); if (!halfn) PG8_MMA(1, 1, At, B1); } PG8_BAR; PG8_SCHED;
        }
        if constexpr (ALIGN_EPI) { if (wr == 0) PG8_BAR; }
        E(acc, cur, wr, wc, fr, fq);
        if (!has_next) break;
#pragma unroll
        for (int a = 0; a < 2; ++a)
#pragma unroll
            for (int b = 0; b < 2; ++b)
#pragma unroll
                for (int m = 0; m < 4; ++m)
#pragma unroll
                    for (int n = 0; n < 2; ++n) acc[a][b][m][n] = (f32x4){0.f, 0.f, 0.f, 0.f};
        cur = nxt; cA = nA; cB = nB; ++ui;
        if constexpr (ALIGN_EPI) { if (wr == 1) PG8_BAR; }
    }
    PG8_WAIT_V(0);
    if constexpr (!ALIGN_EPI) { if (wr == 0) PG8_BAR; }
    PG8_BAR;
#undef PG8_SA
#undef PG8_KOFSA
#undef PG8_KOFSB
#undef PG8_SB
#undef PG8_STAGE
#undef PG8_LDA
#undef PG8_LDB
#undef PG8_MMA
#undef PG8_WAIT_V
#undef PG8_WAIT_L
#undef PG8_BAR
#undef PG8_SCHED
}
}

constexpr int NWAVES = 8;
constexpr size_t MiB = 1u << 20;
constexpr size_t WS_CTL = 0, CTL_ZERO_BYTES = 64 * 1024;
constexpr size_t WS_MOD = 1 * MiB;
constexpr size_t WS_WIN = 2 * MiB;
constexpr size_t WS_WSSD = 21 * MiB;
constexpr size_t WS_WPOOL = 25 * MiB;
constexpr size_t WS_WO = 26 * MiB;
constexpr size_t WS_WUP = 28 * MiB;
constexpr size_t WS_WDOWN = 36 * MiB;
constexpr size_t WS_DT = 44 * MiB;
constexpr size_t WS_HALO = 48 * MiB + 128 * 1024;
constexpr size_t WS_SSQ = 49 * MiB;
constexpr size_t WS_GS = 49 * MiB;
constexpr size_t WS_SLAB = 50 * MiB;
constexpr size_t WS_U = 58 * MiB;
constexpr size_t WS_Z = 123 * MiB;
constexpr size_t WS_XBC = 252 * MiB;
constexpr size_t WS_G = WS_XBC;
constexpr size_t WS_PM = WS_G + (size_t)MPAD * 2048 * 2;
constexpr size_t WS_MIXIN = WS_PM + (size_t)MPAD * 1024 * 2;
constexpr size_t WS_END = WS_XBC + (size_t)MPAD * 4096 * 2;
static_assert(WS_MIXIN + (size_t)MPAD * 1024 * 2 <= WS_END, "ws map");
static_assert(WS_U + (size_t)MPAD * 1024 * 2 <= WS_Z && WS_Z + (size_t)MPAD * 2048 * 2 <= WS_XBC && WS_SSQ + (size_t)MPAD * 64 * 4 <= WS_U && WS_DT + (size_t)MPAD * 32 * 4 <= WS_SSQ, "ws map");
constexpr int CW_BAR = 4096, CW_SCNT = 8192;

constexpr int RING_OFF = 0, RING_BYTES = 131072;
constexpr int LDSCTL_OFF = RING_BYTES, MISC_OFF = LDSCTL_OFF + 320;
constexpr int LDS_BYTES = 147456;

#define GAS __attribute__((address_space(1)))
#define LAS __attribute__((address_space(3)))
typedef unsigned short bf16;
typedef unsigned v4u __attribute__((ext_vector_type(4)));
typedef unsigned v2u __attribute__((ext_vector_type(2)));
typedef float f32x4 __attribute__((ext_vector_type(4)));
typedef short bf16x8 __attribute__((ext_vector_type(8)));
typedef GAS unsigned gu32;
#define RLX_AGENT __ATOMIC_RELAXED, __HIP_MEMORY_SCOPE_AGENT
#define LDS_WAIT() asm volatile("s_waitcnt lgkmcnt(0)" ::: "memory")
using pg8::cvt_pk_bf16; using pg8::bf_lo; using pg8::bf_hi; using pg8::silu_f;

#define XB_TMO      128
#define XB_XCNT(j)  (256  + 64 * (j))
#define XB_XSUB(j)  (1280 + 64 * (j))
#define XB_XGEN(j)  (2304 + 64 * (j))
#define XB_TOP      3328
#define XB_TOPGEN   3392
#define XCD_BAR_WORDS 3456
#define XB_SPIN_CAP (1u << 18)
__device__ __forceinline__ unsigned xb_ld(unsigned* p)              { return __hip_atomic_load(p, __ATOMIC_RELAXED, __HIP_MEMORY_SCOPE_AGENT); }
__device__ __forceinline__ unsigned xb_add(unsigned* p, unsigned v) { return __hip_atomic_fetch_add(p, v, __ATOMIC_RELAXED, __HIP_MEMORY_SCOPE_AGENT); }
__device__ __forceinline__ unsigned xb_xcc_id() { return (unsigned)__builtin_amdgcn_s_getreg((3 << 11) | 20) & 0xFu; }
#define XB_SPIN(cond, bar) do { unsigned _sp = 0; while (cond) { __builtin_amdgcn_s_sleep(1); \
    if ((++_sp & 255u) == 0u) { if (xb_ld(&(bar)[XB_TMO])) break; if (_sp > XB_SPIN_CAP) { atomicAdd(&(bar)[XB_TMO], 1u); break; } } } } while (0)
struct XcdBarrier { unsigned* bar; unsigned x; volatile LAS unsigned* st; };
__device__ __forceinline__ XcdBarrier xcd_barrier_post(unsigned* bar, volatile LAS unsigned* st) {
    XcdBarrier b; b.bar = bar; b.x = xb_xcc_id(); b.st = st;
    if (threadIdx.x == 0) (void)xb_add(&bar[XB_XCNT(b.x)], 1u);
    return b;
}
__device__ __forceinline__ void xcd_barrier_complete(unsigned* bar, unsigned x, unsigned& nloc, unsigned& nx) {
    const unsigned G = gridDim.x * gridDim.y * gridDim.z;
    unsigned sum, cnt, mine, sp = 0u;
    for (;;) {
        sum = 0u; cnt = 0u; mine = 0u;
#pragma unroll
        for (unsigned j = 0; j < 16; ++j) { const unsigned c = xb_ld(&bar[XB_XCNT(j)]); sum += c; cnt += (c > 0u) ? 1u : 0u; mine = (j == x) ? c : mine; }
        if (sum == G) break;
        __builtin_amdgcn_s_sleep(1);
        if ((++sp & 255u) == 0u) { if (xb_ld(&bar[XB_TMO])) break; if (sp > XB_SPIN_CAP) { atomicAdd(&bar[XB_TMO], 1u); break; } }
    }
    nloc = mine > 0u ? mine : 1u; nx = cnt > 0u ? cnt : 1u;
}
__device__ __forceinline__ void xcd_barrier(const XcdBarrier& b) {
    asm volatile("s_waitcnt vmcnt(0)" ::: "memory");
    __syncthreads();
    if (threadIdx.x == 0) {
        unsigned* bar = b.bar;
        __builtin_amdgcn_s_waitcnt(0);
        unsigned nloc = b.st[0], nx = b.st[1];
        if (nloc == 0u) { xcd_barrier_complete(bar, b.x, nloc, nx); b.st[0] = nloc; b.st[1] = nx; }
        const unsigned old = xb_add(&bar[XB_XSUB(b.x)], 1u);
        const unsigned gen = old / nloc;
        if (old + 1u == (gen + 1u) * nloc) {
            __builtin_amdgcn_fence(__ATOMIC_RELEASE, "agent");
            asm volatile("s_waitcnt vmcnt(0)" ::: "memory");
            const unsigned og = xb_add(&bar[XB_TOP], 1u);
            const unsigned tg = og / nx;
            if (og + 1u == (tg + 1u) * nx) xb_add(&bar[XB_TOPGEN], 1u);
            else XB_SPIN(xb_ld(&bar[XB_TOPGEN]) == tg, bar);
            xb_add(&bar[XB_XGEN(b.x)], 1u);
            __builtin_amdgcn_fence(__ATOMIC_ACQUIRE, "agent");
            asm volatile("s_waitcnt vmcnt(0)" ::: "memory");
        } else {
            XB_SPIN(xb_ld(&bar[XB_XGEN(b.x)]) == gen, bar);
            __builtin_amdgcn_fence(__ATOMIC_ACQUIRE, "agent");
            asm volatile("s_waitcnt vmcnt(0)" ::: "memory");
        }
    }
    __syncthreads();
}

struct Args { const float* in[26]; float* out; unsigned char* ws; int ph_lo, ph_hi; };
struct Frame {
    LAS unsigned char* lds;
    int tid, lane, wave, G, bid;
    const float* const* in; float* out; unsigned char* ws;
};
enum { I_XP = 0, I_XS, I_SSM, I_CONV, I_POOL, I_CP, I_CS, I_WADA, I_BADA, I_GPREMIX, I_GPOSTMIX, I_GPREMLP, I_GPOSTMLP, I_WIN, I_CONVW, I_CONVB, I_DTB, I_ALOG, I_DSKIP, I_GSSD,
       I_WSSD, I_WPOOL, I_PSCALE, I_WO, I_WUP, I_WDOWN };

__device__ __forceinline__ float wave_sum(float v) {
#pragma unroll
    for (int o = 1; o < 64; o <<= 1) v += __shfl_xor(v, o);
    return v;
}

__device__ __forceinline__ void p0_transpose_item(const float* W, int ldw, int c0, int k0, bf16* WT, int drow0, int ldk, const float* rs, const float* cs, LAS float* scr, int lane) {
    float tv[32];
#pragma unroll
    for (int i = 0; i < 32; ++i) tv[i] = W[(size_t)(k0 + 2 * i + (lane >> 5)) * ldw + c0 + (lane & 31)];
#pragma unroll
    for (int i = 0; i < 32; ++i) { const int kk = 2 * i + (lane >> 5); float v = tv[i];
        if (rs) v *= rs[k0 + kk]; if (cs) v *= cs[c0 + (lane & 31)]; scr[kk * 33 + (lane & 31)] = v; }
    LDS_WAIT(); asm volatile("" ::: "memory");
    const int c = lane & 7;
#pragma unroll
    for (int j = 0; j < 4; ++j) { const int n = (lane >> 3) + 8 * j; const LAS float* s = scr + (8 * c) * 33 + n;
        v4u o; o.x = cvt_pk_bf16(s[0 * 33], s[1 * 33]); o.y = cvt_pk_bf16(s[2 * 33], s[3 * 33]); o.z = cvt_pk_bf16(s[4 * 33], s[5 * 33]); o.w = cvt_pk_bf16(s[6 * 33], s[7 * 33]);
        const int nd = drow0 == 7168 ? 32 * (n >> 3) + 8 * ((n & 7) >> 1) + (n & 1) : n;
        { const int row = drow0 + nd, nl = row & 255, c32 = nl & 31, slot = (nl & ~31) + 16 * ((c32 >> 2) & 1) + 4 * (c32 >> 3) + (c32 & 3);
          *(GAS v4u*)(WT + ((size_t)((row >> 8) * (ldk / 64) + (k0 >> 6)) * 2048 + pg8::tile_vec(slot, 8 * c)) * 8) = o; } }
    LDS_WAIT(); asm volatile("" ::: "memory");
}
struct TSeg { const float* W; int ldw, c0, ncols, K; bf16* WT; int drow0; const float* rs; const float* cs; };
__device__ __forceinline__ bool p0_seg(const TSeg& s, int& r, LAS float* scr, int lane) {
    const int nblk = s.ncols / 32, items = (s.K / 64) * nblk;
    if (r < items) { const int kb = r / nblk, nb = r % nblk; p0_transpose_item(s.W, s.ldw, s.c0 + 32 * nb, 64 * kb, s.WT, s.drow0 + 32 * nb, s.K, s.rs, s.cs, scr, lane); return true; }
    r -= items; return false;
}
__device__ __forceinline__ void p0_prologue(Frame& F) {
    unsigned char* ws = F.ws;
    bf16* WinT = (bf16*)(ws + WS_WIN);
    const int gw = F.bid * NWAVES + F.wave, NGW = F.G * NWAVES;
    if (F.bid < 96) {
        LAS float* sl = (LAS float*)(F.lds);
        LAS float* red = (LAS float*)(F.lds + 65536);
        { float cv[32];
#pragma unroll
          for (int j = 0; j < 32; ++j) { const int r = j >> 1, k = F.tid + 512 * (j & 1); cv[j] = r < 8 ? F.in[I_CP][r * DM + k] : F.in[I_CS][(r - 8) * DM + k]; }
#pragma unroll
          for (int j = 0; j < 32; ++j) { const int r = j >> 1, k = F.tid + 512 * (j & 1); sl[k * 16 + r] = silu_f(cv[j]); } }
        __syncthreads();
        const int n0 = F.bid * 64; const float* wa = F.in[I_WADA] + n0 + F.lane;
        float acc[16];
#pragma unroll
        for (int r = 0; r < 16; ++r) acc[r] = 0.f;
        const int kb = F.wave * 128;
        for (int k0 = 0; k0 < 128; k0 += 32) {
            float wv[32];
#pragma unroll
            for (int i = 0; i < 32; ++i) wv[i] = wa[(size_t)(kb + k0 + i) * 6144];
#pragma unroll
            for (int i = 0; i < 32; ++i) { const LAS f32x4* sp = (const LAS f32x4*)(sl + (kb + k0 + i) * 16);
#pragma unroll
                for (int r4 = 0; r4 < 4; ++r4) { const f32x4 s = sp[r4]; acc[4 * r4 + 0] += s[0] * wv[i]; acc[4 * r4 + 1] += s[1] * wv[i]; acc[4 * r4 + 2] += s[2] * wv[i]; acc[4 * r4 + 3] += s[3] * wv[i]; } } }
#pragma unroll
        for (int r = 0; r < 16; ++r) red[(F.wave * 16 + r) * 64 + F.lane] = acc[r];
        __syncthreads();
        float* mod = (float*)(ws + WS_MOD);
        for (int i = F.tid; i < 16 * 64; i += NWAVES * 64) { const int r = i >> 6, c = i & 63; float s = F.in[I_BADA][n0 + c];
#pragma unroll
            for (int w = 0; w < 8; ++w) s += red[(w * 16 + r) * 64 + c];
            mod[r * 6144 + n0 + c] = s; }
        __syncthreads();
    }
    LAS float* scr = (LAS float*)(F.lds + RING_OFF + F.wave * 16384);
    const float* w_in = F.in[I_WIN];
    constexpr int NITEMS = 16 * (192 + 32 + 1 + 64) + 32 * 32 + 4 * 4 * 8 + 16 * 32 + 16 * 128 + 64 * 32;
#define P0_SEG(W, ldw, c0, ncols, K, WT, drow0, rs, cs) { const TSeg sg{W, ldw, c0, ncols, K, WT, drow0, rs, cs}; if (p0_seg(sg, r, scr, F.lane)) continue; }
    const int nmodw = (F.G > 96 ? 96 : F.G) * NWAVES, nslots = nmodw + 2 * (NGW - nmodw);
    for (int pass = 0; pass < 2; ++pass) {
      if (pass == 1 && gw < nmodw) break;
      const int slot = gw < nmodw ? gw : nmodw + pass * (NGW - nmodw) + (gw - nmodw);
      for (int it = slot; it < NITEMS; it += nslots) {
        int r = it;
        P0_SEG(w_in, 9248, 0, 6144, 1024, WinT, 0, nullptr, nullptr)
        P0_SEG(w_in, 9248, 6176, 1024, 1024, WinT, 6144, nullptr, nullptr)
        P0_SEG(w_in, 9248, 6144, 32, 1024, WinT, 7168, nullptr, nullptr)
        P0_SEG(w_in, 9248, 7200, 2048, 1024, WinT, 7424, nullptr, nullptr)
        P0_SEG(F.in[I_WSSD], 1024, 0, 1024, 2048, (bf16*)(ws + WS_WSSD), 0, F.in[I_GSSD], nullptr)
        P0_SEG(F.in[I_WPOOL] + 0 * 65536, 256, 0, 256, 256, (bf16*)(ws + WS_WPOOL), 0, nullptr, F.in[I_PSCALE] + 0)
        P0_SEG(F.in[I_WPOOL] + 1 * 65536, 256, 0, 256, 256, (bf16*)(ws + WS_WPOOL), 256, nullptr, F.in[I_PSCALE] + 256)
        P0_SEG(F.in[I_WPOOL] + 2 * 65536, 256, 0, 256, 256, (bf16*)(ws + WS_WPOOL), 512, nullptr, F.in[I_PSCALE] + 512)
        P0_SEG(F.in[I_WPOOL] + 3 * 65536, 256, 0, 256, 256, (bf16*)(ws + WS_WPOOL), 768, nullptr, F.in[I_PSCALE] + 768)
        P0_SEG(F.in[I_WO], 1024, 0, 1024, 1024, (bf16*)(ws + WS_WO), 0, nullptr, nullptr)
        P0_SEG(F.in[I_WUP], 4096, 0, 4096, 1024, (bf16*)(ws + WS_WUP), 0, nullptr, nullptr)
        P0_SEG(F.in[I_WDOWN], 1024, 0, 1024, 4096, (bf16*)(ws + WS_WDOWN), 0, nullptr, nullptr)
      }
    }
#undef P0_SEG
    { GAS v4u* z = (GAS v4u*)(WinT + (size_t)7168 * 1024); const int n16 = 256 * 1024 * 2 / 16;
      for (int i = F.bid * NWAVES * 64 + F.tid; i < n16; i += F.G * NWAVES * 64) { const int r = i >> 7, ch = i & 127, c32 = r & 31, slot = (r & ~31) + 16 * ((c32 >> 2) & 1) + 4 * (c32 >> 3) + (c32 & 3);
          if (!(r < 128 && (r & 7) < 2)) z[(ch >> 3) * 2048 + pg8::tile_vec(slot, 8 * (ch & 7))] = (v4u){0u, 0u, 0u, 0u}; } }
}

__device__ __forceinline__ const float* x_row(Frame& F, int m) { return m < MP ? F.in[I_XP] + (size_t)m * DM : F.in[I_XS] + (size_t)(m - MP) * DM; }
__device__ __forceinline__ int mod_row(int m) { return m < MP ? (m >> 12) : 8 + ((m - MP) >> 4); }
__device__ __forceinline__ void u_row(const f32x4 (&v)[4], const f32x4 (&gs)[4], const f32x4 (&sh)[4], bf16* urow, int lane) {
    float s2 = 0.f;
#pragma unroll
    for (int j = 0; j < 4; ++j) s2 += (v[j].x * v[j].x + v[j].y * v[j].y) + (v[j].z * v[j].z + v[j].w * v[j].w);
    const float rstd = rsqrtf(wave_sum(s2) * (1.f / DM) + EPS);
    GAS v2u* o8 = (GAS v2u*)urow + lane;
#pragma unroll
    for (int j = 0; j < 4; ++j) { const f32x4 o = v[j] * rstd * gs[j] + sh[j]; o8[64 * j] = (v2u){cvt_pk_bf16(o.x, o.y), cvt_pk_bf16(o.z, o.w)}; }
}
__device__ __forceinline__ void p1_u(Frame& F) {
    const int gw = F.bid * NWAVES + F.wave, NGW = F.G * NWAVES, lane = F.lane;
    const float* mod = (const float*)(F.ws + WS_MOD); bf16* U = (bf16*)(F.ws + WS_U);
    const float* gp = F.in[I_GPREMIX];
    for (int m = MP + (NGW - 1 - gw); m < MPAD; m += NGW) {
        if (m >= MR) { GAS v2u* o8 = (GAS v2u*)(U + (size_t)m * DM) + lane;
#pragma unroll
            for (int j = 0; j < 4; ++j) o8[64 * j] = (v2u){0u, 0u};
            continue; }
        const float* md = mod + mod_row(m) * 6144;
        f32x4 gs[4], sh[4], v[4];
        const GAS f32x4* xr = (const GAS f32x4*)x_row(F, m) + lane;
#pragma unroll
        for (int j = 0; j < 4; ++j) { const int k = 4 * lane + 256 * j; v[j] = xr[64 * j]; gs[j] = *(const f32x4*)(gp + k) * (*(const f32x4*)(md + 1024 + k) + 1.0f); sh[j] = *(const f32x4*)(md + k); }
        u_row(v, gs, sh, U + (size_t)m * DM, lane);
    }
    for (int blk = gw; blk < MP / 16; blk += NGW) {
        const int m0 = blk * 16;
        const float* md = mod + mod_row(m0) * 6144;
        f32x4 gs[4], sh[4];
#pragma unroll
        for (int j = 0; j < 4; ++j) { const int k = 4 * lane + 256 * j; gs[j] = *(const f32x4*)(gp + k) * (*(const f32x4*)(md + 1024 + k) + 1.0f); sh[j] = *(const f32x4*)(md + k); }
        for (int r = 0; r < 16; r += 2) {
            f32x4 v0[4], v1[4];
            const GAS f32x4* x0 = (const GAS f32x4*)x_row(F, m0 + r) + lane; const GAS f32x4* x1 = (const GAS f32x4*)x_row(F, m0 + r + 1) + lane;
#pragma unroll
            for (int j = 0; j < 4; ++j) { v0[j] = x0[64 * j]; v1[j] = x1[64 * j]; }
            u_row(v0, gs, sh, U + (size_t)(m0 + r) * DM, lane); u_row(v1, gs, sh, U + (size_t)(m0 + r + 1) * DM, lane);
        }
    }
}

__device__ __forceinline__ void conv8_row(const float (&cw)[4][8], const float (&cb)[8], float (&win)[3][8], const v4u raw, v4u& outp) {
    float x[8] = {bf_lo(raw.x), bf_hi(raw.x), bf_lo(raw.y), bf_hi(raw.y), bf_lo(raw.z), bf_hi(raw.z), bf_lo(raw.w), bf_hi(raw.w)};
    float o[8];
#pragma unroll
    for (int e = 0; e < 8; ++e) { o[e] = silu_f(cb[e] + cw[0][e] * win[0][e] + cw[1][e] * win[1][e] + cw[2][e] * win[2][e] + cw[3][e] * x[e]); win[0][e] = win[1][e]; win[1][e] = win[2][e]; win[2][e] = x[e]; }
    outp = (v4u){cvt_pk_bf16(o[0], o[1]), cvt_pk_bf16(o[2], o[3]), cvt_pk_bf16(o[4], o[5]), cvt_pk_bf16(o[6], o[7])};
}
__device__ __forceinline__ void p2b_conv_bc(Frame& F) {
    bf16* XBC = (bf16*)(F.ws + WS_XBC); const bf16* HALO = (const bf16*)(F.ws + WS_HALO);
    const int tid = F.tid, cg = tid & 63, seg = tid >> 6;
    for (int item = F.bid; item < 256; item += F.G) {
        const int b = item >> 5, q = (item >> 3) & 3, rr = item & 7, col = 2048 + (q * 64 + cg) * 8;
        float cw[4][8], cb[8];
#pragma unroll
        for (int k = 0; k < 4; ++k) { const f32x4 a0 = *(const f32x4*)(F.in[I_CONVW] + k * CONVD + col), a1 = *(const f32x4*)(F.in[I_CONVW] + k * CONVD + col + 4);
            cw[k][0] = a0.x; cw[k][1] = a0.y; cw[k][2] = a0.z; cw[k][3] = a0.w; cw[k][4] = a1.x; cw[k][5] = a1.y; cw[k][6] = a1.z; cw[k][7] = a1.w; }
        { const f32x4 a0 = *(const f32x4*)(F.in[I_CONVB] + col), a1 = *(const f32x4*)(F.in[I_CONVB] + col + 4);
          cb[0] = a0.x; cb[1] = a0.y; cb[2] = a0.z; cb[3] = a0.w; cb[4] = a1.x; cb[5] = a1.y; cb[6] = a1.z; cb[7] = a1.w; }
        bf16* base = XBC + ((size_t)b * SEQ + (size_t)rr * 512 + (size_t)seg * 64) * CONVD + col;
        float win[3][8];
#pragma unroll
        for (int i = 0; i < 3; ++i) { v4u r = (v4u){0u, 0u, 0u, 0u};
            if (seg > 0) r = *(const GAS v4u*)(base - (size_t)(3 - i) * CONVD);
            else if (rr > 0) r = *(const GAS v4u*)(HALO + ((size_t)((b * 8 + rr) * 3 + i)) * 2048 + (col - 2048));
            win[i][0] = bf_lo(r.x); win[i][1] = bf_hi(r.x); win[i][2] = bf_lo(r.y); win[i][3] = bf_hi(r.y); win[i][4] = bf_lo(r.z); win[i][5] = bf_hi(r.z); win[i][6] = bf_lo(r.w); win[i][7] = bf_hi(r.w); }
        asm volatile("s_waitcnt vmcnt(0)" ::: "memory");
        __syncthreads();
        for (int blk = 0; blk < 8; ++blk) {
            v4u rw[8];
#pragma unroll
            for (int i = 0; i < 8; ++i) rw[i] = *(const GAS v4u*)(base + (size_t)(blk * 8 + i) * CONVD);
#pragma unroll
            for (int i = 0; i < 8; ++i) { v4u o; conv8_row(cw, cb, win, rw[i], o); *(GAS v4u*)(base + (size_t)(blk * 8 + i) * CONVD) = o; }
        }
        __syncthreads();
    }
}

constexpr int SS_CM = 0, SS_BM = 17408, SS_BWT = 34816, SS_XT = 53248, SS_XR = 71680, SS_GP = 90112, SS_HB = 108544, SS_SC = 125952, SS_PAR = 9216;
static_assert(SS_SC + 2 * 1280 <= RING_BYTES, "SSD LDS map");
constexpr int SS_XRAW = 132096;
static_assert(SS_XRAW >= MISC_OFF + 128 && SS_XRAW + 72 * 144 <= LDS_BYTES, "SSD raw image");
__device__ __forceinline__ bf16x8 ldfrag(LAS unsigned char* base, int row, int stride, int kbyte) { return *(const LAS bf16x8*)(base + row * stride + kbyte); }
__device__ __forceinline__ v4u pack8f(const float* f) { v4u o; o.x = cvt_pk_bf16(f[0], f[1]); o.y = cvt_pk_bf16(f[2], f[3]); o.z = cvt_pk_bf16(f[4], f[5]); o.w = cvt_pk_bf16(f[6], f[7]); return o; }

template <bool sample> __device__ __forceinline__ void ssd_unit(Frame& F, int b, int h) {
    LAS unsigned char* lds = F.lds;
    const int tid = F.tid, lane = F.lane, w = F.wave, r16 = lane & 15, q = lane >> 4;
    constexpr int CS = 64;
    const int g = h >> 2; constexpr int L = sample ? DSEQ : SEQ, nch = sample ? 1 : SEQ / CS, valid = sample ? DSEQ : CS;
    const size_t m0 = sample ? (size_t)(MP + b * DSEQ) : (size_t)b * SEQ;
    const float a = -__expf(F.in[I_ALOG][h]), Dh = F.in[I_DSKIP][h];
    const bf16* XBC = (const bf16*)(F.ws + WS_XBC); bf16* Zb = (bf16*)(F.ws + WS_Z);
    const float* DT = (const float*)(F.ws + WS_DT);
    const float* hist = F.in[I_CONV] + (size_t)b * 3 * CONVD;
    f32x4 acch[4];
#pragma unroll
    for (int pt = 0; pt < 4; ++pt) {
        if (sample) acch[pt] = *(const f32x4*)(F.in[I_SSM] + (((size_t)(b * NHEAD + h) * 64 + pt * 16 + r16) * 128 + w * 16 + 4 * q));
        else acch[pt] = (f32x4){0.f, 0.f, 0.f, 0.f}; }
    const int pp = tid & 31, xl0 = (tid >> 5) * 4, xcol = h * 64 + 2 * pp;
    float wk[4][2], bb[2];
#pragma unroll
    for (int k = 0; k < 4; ++k) { wk[k][0] = F.in[I_CONVW][k * CONVD + xcol]; wk[k][1] = F.in[I_CONVW][k * CONVD + xcol + 1]; }
    bb[0] = F.in[I_CONVB][xcol]; bb[1] = F.in[I_CONVB][xcol + 1];
    const bool isB = tid < 256; const int cg = tid & 15, bl0 = ((tid >> 4) & 15) * 4, bccol = (isB ? 2048 : 3072) + g * 128 + cg * 8;
    v4u bcraw[4], xr9[2];
    auto load_xraw = [&](int c) {
#pragma unroll
        for (int k = 0; k < 2; ++k) { const int i = k == 0 ? w : 8; const int r = 8 * i + (lane >> 3), t = c * CS - 3 + r, cc = h * 64 + (lane & 7) * 8;
            if (k == 1 && w != 0) break;
            if (r < 67 && t >= 0 && t < L) xr9[k] = *(const GAS v4u*)(XBC + (m0 + t) * CONVD + cc);
            else if (r < 67 && t < 0 && sample) { const float* hp = hist + (size_t)(3 + t) * CONVD + cc; const f32x4 a0 = *(const f32x4*)hp, a1 = *(const f32x4*)(hp + 4);
                xr9[k] = (v4u){cvt_pk_bf16(a0.x, a0.y), cvt_pk_bf16(a0.z, a0.w), cvt_pk_bf16(a1.x, a1.y), cvt_pk_bf16(a1.z, a1.w)}; }
            else xr9[k] = (v4u){0u, 0u, 0u, 0u}; }
    };
    auto write_xraw = [&]() {
        *(LAS v4u*)(lds + SS_XRAW + (8 * w + (lane >> 3)) * 144 + (lane & 7) * 16) = xr9[0];
        if (w == 0) *(LAS v4u*)(lds + SS_XRAW + (64 + (lane >> 3)) * 144 + (lane & 7) * 16) = xr9[1];
    };
    auto load_raw = [&](int c) {
#pragma unroll
        for (int i = 0; i < 4; ++i) { const int t = c * CS + bl0 + i;
            bcraw[i] = (!sample || bl0 + i < valid) ? *(const GAS v4u*)(XBC + (m0 + t) * CONVD + bccol) : (v4u){0u, 0u, 0u, 0u}; }
    };
    auto scalars = [&](int par, float dtl) {
        LAS float* sc = (LAS float*)(lds + SS_SC + par * 1280);
        float x = dtl * a;
#define SSD_DPP_ADD(ctrl, rmask) x += __builtin_bit_cast(float, __builtin_amdgcn_update_dpp(0, __builtin_bit_cast(int, x), ctrl, rmask, 0xf, true))
        SSD_DPP_ADD(0x111, 0xf); SSD_DPP_ADD(0x112, 0xf); SSD_DPP_ADD(0x114, 0xf); SSD_DPP_ADD(0x118, 0xf);
        SSD_DPP_ADD(0x142, 0xa); SSD_DPP_ADD(0x143, 0xc);
#undef SSD_DPP_ADD
        const float aend = __builtin_bit_cast(float, __builtin_amdgcn_readlane(__builtin_bit_cast(int, x), 63));
        sc[lane] = x; sc[64 + lane] = dtl; sc[128 + lane] = __expf(aend - x) * dtl; sc[192 + lane] = __expf(x); if (lane == 0) sc[256] = __expf(aend);
    };
    const int zlt = w & 3, zhh = w >> 2, zlrow = zlt * 16 + r16;
    v2u zraw[2];
    auto load_z = [&](int c) {
#pragma unroll
        for (int j = 0; j < 2; ++j) zraw[j] = (!sample || zlrow < valid) ? *(const GAS v2u*)(Zb + (m0 + (size_t)c * CS + zlrow) * DIN + h * 64 + (2 * zhh + j) * 16 + 4 * q) : (v2u){0u, 0u};
    };
    if constexpr (sample) {
        if (bl0 < valid) {
            float cw[4][8], cb[8], win[3][8];
#pragma unroll
            for (int k = 0; k < 4; ++k) { const f32x4 a0 = *(const f32x4*)(F.in[I_CONVW] + k * CONVD + bccol), a1 = *(const f32x4*)(F.in[I_CONVW] + k * CONVD + bccol + 4);
                cw[k][0] = a0.x; cw[k][1] = a0.y; cw[k][2] = a0.z; cw[k][3] = a0.w; cw[k][4] = a1.x; cw[k][5] = a1.y; cw[k][6] = a1.z; cw[k][7] = a1.w; }
            { const f32x4 a0 = *(const f32x4*)(F.in[I_CONVB] + bccol), a1 = *(const f32x4*)(F.in[I_CONVB] + bccol + 4);
              cb[0] = a0.x; cb[1] = a0.y; cb[2] = a0.z; cb[3] = a0.w; cb[4] = a1.x; cb[5] = a1.y; cb[6] = a1.z; cb[7] = a1.w; }
#pragma unroll
            for (int i = 0; i < 3; ++i) { const int t = bl0 - 3 + i; v4u r;
                if (t >= 0) r = *(const GAS v4u*)(XBC + (m0 + t) * CONVD + bccol);
                else { const float* hp = hist + (size_t)(3 + t) * CONVD + bccol; const f32x4 a0 = *(const f32x4*)hp, a1 = *(const f32x4*)(hp + 4);
                    r = (v4u){cvt_pk_bf16(a0.x, a0.y), cvt_pk_bf16(a0.z, a0.w), cvt_pk_bf16(a1.x, a1.y), cvt_pk_bf16(a1.z, a1.w)}; }
                win[i][0] = bf_lo(r.x); win[i][1] = bf_hi(r.x); win[i][2] = bf_lo(r.y); win[i][3] = bf_hi(r.y); win[i][4] = bf_lo(r.z); win[i][5] = bf_hi(r.z); win[i][6] = bf_lo(r.w); win[i][7] = bf_hi(r.w); }
#pragma unroll
            for (int i = 0; i < 4; ++i) { const v4u raw = *(const GAS v4u*)(XBC + (m0 + bl0 + i) * CONVD + bccol); conv8_row(cw, cb, win, raw, bcraw[i]); }
        } else {
#pragma unroll
            for (int i = 0; i < 4; ++i) bcraw[i] = (v4u){0u, 0u, 0u, 0u}; }
    } else load_raw(0);
    load_z(0);
    load_xraw(0); write_xraw(); if (nch > 1) load_xraw(1);
    float dtn = 0.f;
    if (w == 0) { scalars(0, (!sample || lane < valid) ? DT[(m0 + lane) * 32 + h] : 0.f); if (nch > 1) dtn = DT[(m0 + CS + lane) * 32 + h]; }
    __syncthreads();
    for (int c = 0; c < nch; ++c) {
        const int par = c & 1;
        LAS float* sc = (LAS float*)(lds + SS_SC + par * 1280);
        LAS unsigned char* XT = lds + SS_XT + par * SS_PAR; LAS unsigned char* XR = lds + SS_XR + par * SS_PAR; LAS unsigned char* GP = lds + SS_GP + par * SS_PAR;
        { float xin[7][2];
#pragma unroll
          for (int i = 0; i < 7; ++i) { const unsigned xu = *(const LAS unsigned*)(lds + SS_XRAW + (xl0 + i) * 144 + pp * 4); xin[i][0] = bf_lo(xu); xin[i][1] = bf_hi(xu); }
          float o[2][4];
#pragma unroll
          for (int i = 0; i < 4; ++i)
#pragma unroll
              for (int e = 0; e < 2; ++e) { const float v = bb[e] + wk[0][e] * xin[i][e] + wk[1][e] * xin[i + 1][e] + wk[2][e] * xin[i + 2][e] + wk[3][e] * xin[i + 3][e];
                  o[e][i] = (!sample || xl0 + i < valid) ? silu_f(v) : 0.f; }
#pragma unroll
          for (int e = 0; e < 2; ++e) *(LAS v2u*)(XT + (2 * pp + e) * 144 + xl0 * 2) = (v2u){cvt_pk_bf16(o[e][0], o[e][1]), cvt_pk_bf16(o[e][2], o[e][3])};
#pragma unroll
          for (int i = 0; i < 4; ++i) *(LAS unsigned*)(XR + (xl0 + i) * 144 + pp * 4) = cvt_pk_bf16(o[0][i], o[1][i]);
          if (isB) {
#pragma unroll
              for (int i = 0; i < 4; ++i) *(LAS v4u*)(lds + SS_BM + (bl0 + i) * 272 + cg * 16) = bcraw[i];
              const f32x4 wv = *(const LAS f32x4*)(sc + 128 + bl0);
              const int bwsw = (((bl0 >> 3) ^ (cg >> 1)) << 4) + ((bl0 >> 2) & 1) * 8;
#pragma unroll
              for (int e = 0; e < 4; ++e) {
                  const unsigned u0 = e == 0 ? bcraw[0].x : (e == 1 ? bcraw[0].y : (e == 2 ? bcraw[0].z : bcraw[0].w));
                  const unsigned u1 = e == 0 ? bcraw[1].x : (e == 1 ? bcraw[1].y : (e == 2 ? bcraw[1].z : bcraw[1].w));
                  const unsigned u2 = e == 0 ? bcraw[2].x : (e == 1 ? bcraw[2].y : (e == 2 ? bcraw[2].z : bcraw[2].w));
                  const unsigned u3 = e == 0 ? bcraw[3].x : (e == 1 ? bcraw[3].y : (e == 2 ? bcraw[3].z : bcraw[3].w));
                  *(LAS v2u*)(lds + SS_BWT + (cg * 8 + 2 * e) * 144 + bwsw) = (v2u){cvt_pk_bf16(bf_lo(u0) * wv[0], bf_lo(u1) * wv[1]), cvt_pk_bf16(bf_lo(u2) * wv[2], bf_lo(u3) * wv[3])};
                  *(LAS v2u*)(lds + SS_BWT + (cg * 8 + 2 * e + 1) * 144 + bwsw) = (v2u){cvt_pk_bf16(bf_hi(u0) * wv[0], bf_hi(u1) * wv[1]), cvt_pk_bf16(bf_hi(u2) * wv[2], bf_hi(u3) * wv[3])}; }
          } else {
#pragma unroll
              for (int i = 0; i < 4; ++i) *(LAS v4u*)(lds + SS_CM + (bl0 + i) * 272 + cg * 16) = bcraw[i];
          }
          if (c + 1 < nch) load_raw(c + 1);
        }
#pragma unroll
        for (int pt = 0; pt < 4; ++pt) *(LAS v2u*)(lds + SS_HB + (pt * 16 + r16) * 272 + (w * 16 + 4 * q) * 2) = (v2u){cvt_pk_bf16(acch[pt][0], acch[pt][1]), cvt_pk_bf16(acch[pt][2], acch[pt][3])};
        __syncthreads();
        if (w == 0 && c + 1 < nch) { scalars(par ^ 1, dtn); if (c + 2 < nch) dtn = DT[(m0 + (size_t)(c + 2) * CS + lane) * 32 + h]; }
        if (c + 1 < nch) { write_xraw(); if (c + 2 < nch) load_xraw(c + 2); }
        const int lt = w & 3, hh = w >> 2, lrow = lt * 16 + r16;
        const size_t mrow = m0 + (size_t)c * CS + lrow;
        const bool rowok = !sample || lrow < valid;
        bf16x8 cf[4];
#pragma unroll
        for (int ks = 0; ks < 4; ++ks) cf[ks] = ldfrag(lds + SS_CM, lrow, 272, ks * 64 + q * 16);
#pragma unroll
        for (int j = 0; j < 2; ++j) { const int st = 2 * hh + j; f32x4 d = (f32x4){0.f, 0.f, 0.f, 0.f};
#pragma unroll
            for (int ks = 0; ks < 4; ++ks) d = __builtin_amdgcn_mfma_f32_16x16x32_bf16(ldfrag(lds + SS_BM, st * 16 + r16, 272, ks * 64 + q * 16), cf[ks], d, 0, 0, 0);
            const int s0 = st * 16 + 4 * q; const float al = sc[lrow];
            const f32x4 as = *(const LAS f32x4*)(sc + s0), ds = *(const LAS f32x4*)(sc + 64 + s0);
            float gv[4];
#pragma unroll
            for (int r = 0; r < 4; ++r) gv[r] = (lrow >= s0 + r) ? d[r] * __expf(al - as[r]) * ds[r] : 0.f;
            *(LAS v2u*)(GP + lrow * 144 + s0 * 2) = (v2u){cvt_pk_bf16(gv[0], gv[1]), cvt_pk_bf16(gv[2], gv[3])}; }
        f32x4 yoff[2];
#pragma unroll
        for (int j = 0; j < 2; ++j) { const int pt = 2 * hh + j; f32x4 d = (f32x4){0.f, 0.f, 0.f, 0.f};
#pragma unroll
            for (int ks = 0; ks < 4; ++ks) d = __builtin_amdgcn_mfma_f32_16x16x32_bf16(ldfrag(lds + SS_HB, pt * 16 + r16, 272, ks * 64 + q * 16), cf[ks], d, 0, 0, 0);
            yoff[j] = d; }
        { const float dend = sc[256];
          bf16x8 wf[2];
#pragma unroll
          for (int ks = 0; ks < 2; ++ks) wf[ks] = ldfrag(lds + SS_BWT, w * 16 + r16, 144, ((ks * 4 + q) ^ w) * 16);
#pragma unroll
          for (int pt = 0; pt < 4; ++pt) { acch[pt] = acch[pt] * dend;
#pragma unroll
              for (int ks = 0; ks < 2; ++ks) acch[pt] = __builtin_amdgcn_mfma_f32_16x16x32_bf16(wf[ks], ldfrag(XT, pt * 16 + r16, 144, ks * 64 + q * 16), acch[pt], 0, 0, 0); } }
        __syncthreads();
        { bf16x8 gf[2];
#pragma unroll
          for (int ks = 0; ks < 2; ++ks) gf[ks] = ldfrag(GP, lrow, 144, ks * 64 + q * 16);
          const float el = sc[192 + lrow];
#pragma unroll
          for (int j = 0; j < 2; ++j) { const int pt = 2 * hh + j, p0 = pt * 16 + 4 * q; f32x4 d = (f32x4){0.f, 0.f, 0.f, 0.f};
#pragma unroll
              for (int ks = 0; ks < 2; ++ks) d = __builtin_amdgcn_mfma_f32_16x16x32_bf16(ldfrag(XT, pt * 16 + r16, 144, ks * 64 + q * 16), gf[ks], d, 0, 0, 0);
              const v2u xr = *(const LAS v2u*)(XR + lrow * 144 + p0 * 2);
              const float xv[4] = {bf_lo(xr.x), bf_hi(xr.x), bf_lo(xr.y), bf_hi(xr.y)};
              const float zv[4] = {bf_lo(zraw[j].x), bf_hi(zraw[j].x), bf_lo(zraw[j].y), bf_hi(zraw[j].y)};
              float yz[4];
#pragma unroll
              for (int r = 0; r < 4; ++r) yz[r] = (d[r] + el * yoff[j][r] + Dh * xv[r]) * zv[r];
              if (rowok) *(GAS v2u*)(Zb + mrow * DIN + h * 64 + p0) = (v2u){cvt_pk_bf16(yz[0], yz[1]), cvt_pk_bf16(yz[2], yz[3])}; }
          if (c + 1 < nch) load_z(c + 1); }
    }
    { float* so = F.out + (sample ? OFF_SSM_S : OFF_SSM_P) + (size_t)(b * NHEAD + h) * 64 * 128;
#pragma unroll
      for (int pt = 0; pt < 4; ++pt) *(f32x4*)(so + (size_t)(pt * 16 + r16) * 128 + w * 16 + 4 * q) = acch[pt]; }
    __syncthreads();
}
__device__ __forceinline__ void p3_ssd(Frame& F) {
    for (int u = F.bid; u < 256; u += F.G) ssd_unit<false>(F, u >> 5, u & 31);
    for (int u = F.bid; u < 256; u += F.G) ssd_unit<true>(F, u >> 5, u & 31);
}

__device__ __forceinline__ void p4_norm_pool(Frame& F) {
    const int gw = F.bid * NWAVES + F.wave, NGW = F.G * NWAVES, lane = F.lane;
    bf16* Zb = (bf16*)(F.ws + WS_Z);
    const bool bal = NGW == 2048; const bool heavy = bal && gw >= 2032;
    const int nbase = bal ? (heavy ? 3 : 16) : (MR - gw + NGW - 1) / NGW, nrows = nbase + ((bal && gw < 336) ? 1 : 0);
    auto row_of = [&](int i) -> int { if (i < nbase) return gw + i * NGW; return gw < 208 ? 2032 + (gw & 15) + (3 + (gw >> 4)) * 2048 : MP + (gw - 208); };
    for (int i0 = 0; i0 < nrows; i0 += 2) {
        v4u vv[2][4]; int mrow[2];
#pragma unroll
        for (int r = 0; r < 2; ++r) { mrow[r] = i0 + r < nrows ? row_of(i0 + r) : -1;
            if (mrow[r] >= 0) { const GAS v4u* zr = (const GAS v4u*)(Zb + (size_t)mrow[r] * DIN) + lane;
#pragma unroll
                for (int j = 0; j < 4; ++j) vv[r][j] = zr[64 * j]; } }
#pragma unroll
        for (int r = 0; r < 2; ++r) { const int m = mrow[r]; if (m < 0) continue;
            GAS v4u* zr = (GAS v4u*)(Zb + (size_t)m * DIN) + lane;
#pragma unroll
            for (int j = 0; j < 4; ++j) { const v4u v = vv[r][j];
                float a = bf_lo(v.x) * bf_lo(v.x) + bf_hi(v.x) * bf_hi(v.x) + bf_lo(v.y) * bf_lo(v.y) + bf_hi(v.y) * bf_hi(v.y) + bf_lo(v.z) * bf_lo(v.z) + bf_hi(v.z) * bf_hi(v.z) + bf_lo(v.w) * bf_lo(v.w) + bf_hi(v.w) * bf_hi(v.w);
#pragma unroll
                for (int o = 1; o < 32; o <<= 1) a += __shfl_xor(a, o);
                const float rr = rsqrtf(a * (1.f / 256.f) + EPS);
                v4u w;
                w.x = cvt_pk_bf16(bf_lo(v.x) * rr, bf_hi(v.x) * rr); w.y = cvt_pk_bf16(bf_lo(v.y) * rr, bf_hi(v.y) * rr);
                w.z = cvt_pk_bf16(bf_lo(v.z) * rr, bf_hi(v.z) * rr); w.w = cvt_pk_bf16(bf_lo(v.w) * rr, bf_hi(v.w) * rr);
                zr[64 * j] = w; } }
    }
    const bf16* P = (const bf16*)F.out; bf16* PM = (bf16*)(F.ws + WS_PM);
    const int gt = F.bid * (NWAVES * 64) + F.tid, NGT = F.G * NWAVES * 64;
    for (int it = 0; ; ++it) {
        int idx;
        if (NGT == 131072) { if (it == 0) idx = gt; else if (it == 1 && gt >= 131072 - 1024) idx = 131072 + (gt - (131072 - 1024)); else break; }
        else { idx = gt + it * NGT; if (idx >= 131072 + 1024) break; }
        const bool sample = idx >= 131072; const int id = sample ? idx - 131072 : idx;
        const int cgp = id & 127, b = sample ? (id >> 7) : (id >> 14), rbk = sample ? 0 : ((id >> 7) & 127);
        const int wl = 2 << (cgp >> 5), t0 = rbk * 32, nrow = sample ? DSEQ : 32;
        const size_t mb = sample ? (size_t)(MP + b * DSEQ) : (size_t)b * SEQ;
        const float* hp = F.in[I_POOL] + (size_t)b * 15 * DM + cgp * 8;
        auto ldp = [&](int t, bool on, float* f) {
            if (on && t >= 0) { const v4u v = *(const GAS v4u*)(P + (mb + t) * DM + cgp * 8);
                f[0] = bf_lo(v.x); f[1] = bf_hi(v.x); f[2] = bf_lo(v.y); f[3] = bf_hi(v.y); f[4] = bf_lo(v.z); f[5] = bf_hi(v.z); f[6] = bf_lo(v.w); f[7] = bf_hi(v.w); }
            else if (on && sample) { const float* q = hp + (size_t)(15 + t) * DM; const f32x4 a0 = *(const f32x4*)q, a1 = *(const f32x4*)(q + 4);
                f[0] = a0.x; f[1] = a0.y; f[2] = a0.z; f[3] = a0.w; f[4] = a1.x; f[5] = a1.y; f[6] = a1.z; f[7] = a1.w; }
            else {
#pragma unroll
                for (int e = 0; e < 8; ++e) f[e] = 0.f; }
        };
        float sum[8];
#pragma unroll
        for (int e = 0; e < 8; ++e) sum[e] = 0.f;
        { float h[15][8];
#pragma unroll
          for (int i = 1; i < 16; ++i) ldp(t0 - i, i < wl, h[i - 1]);
#pragma unroll
          for (int i = 0; i < 15; ++i)
#pragma unroll
              for (int e = 0; e < 8; ++e) sum[e] += h[i][e]; }
        for (int tb = t0; tb < t0 + nrow; tb += 8) {
            float cur[8][8], old[8][8];
#pragma unroll
            for (int i = 0; i < 8; ++i) { ldp(tb + i, true, cur[i]); ldp(tb + i - wl + 1, true, old[i]); }
#pragma unroll
            for (int i = 0; i < 8; ++i) { const int t = tb + i;
                const int cnt = sample ? wl : (t + 1 < wl ? t + 1 : wl); const float inv = 1.0f / (float)cnt;
                float o[8];
#pragma unroll
                for (int e = 0; e < 8; ++e) { sum[e] += cur[i][e]; o[e] = sum[e] * inv - cur[i][e]; sum[e] -= old[i][e]; }
                *(GAS v4u*)(PM + (mb + t) * DM + cgp * 8) = pack8f(o); }
        }
    }
}

__device__ __forceinline__ void post_row(const f32x4 (&v)[4], const f32x4 (&bs)[4], const f32x4 (&gg)[4], const f32x4 (&gs2)[4], const f32x4 (&sh2)[4], bool first,
                                         bf16* x1b, bf16* vrow, float* orow, int lane) {
    float s2 = 0.f;
#pragma unroll
    for (int j = 0; j < 4; ++j) s2 += (v[j].x * v[j].x + v[j].y * v[j].y) + (v[j].z * v[j].z + v[j].w * v[j].w);
    const float rstd = rsqrtf(wave_sum(s2) * (1.f / DM) + EPS);
    f32x4 x1[4]; float q2 = 0.f;
#pragma unroll
    for (int j = 0; j < 4; ++j) { x1[j] = bs[j] + gg[j] * (v[j] * rstd);
        q2 += (x1[j].x * x1[j].x + x1[j].y * x1[j].y) + (x1[j].z * x1[j].z + x1[j].w * x1[j].w); }
    if (first) {
        GAS v4u* xw = (GAS v4u*)x1b + lane;
#pragma unroll
        for (int jp = 0; jp < 2; ++jp) xw[64 * jp] = (v4u){cvt_pk_bf16(x1[2 * jp].x, x1[2 * jp].y), cvt_pk_bf16(x1[2 * jp].z, x1[2 * jp].w), cvt_pk_bf16(x1[2 * jp + 1].x, x1[2 * jp + 1].y), cvt_pk_bf16(x1[2 * jp + 1].z, x1[2 * jp + 1].w)};
        const float r2 = rsqrtf(wave_sum(q2) * (1.f / DM) + EPS);
        GAS v2u* o8 = (GAS v2u*)vrow + lane;
#pragma unroll
        for (int j = 0; j < 4; ++j) { const f32x4 o = x1[j] * r2 * gs2[j] + sh2[j]; o8[64 * j] = (v2u){cvt_pk_bf16(o.x, o.y), cvt_pk_bf16(o.z, o.w)}; }
    } else {
        GAS f32x4* ow = (GAS f32x4*)orow + lane;
#pragma unroll
        for (int j = 0; j < 4; ++j) ow[64 * j] = x1[j];
    }
}
__device__ __forceinline__ void p_post(Frame& F, const bf16* S, bool first, const float* slab, int nsl) {
    const int gw = F.bid * NWAVES + F.wave, NGW = F.G * NWAVES, lane = F.lane;
    const float* mod = (const float*)(F.ws + WS_MOD); bf16* V = (bf16*)(F.ws + WS_U);
    bf16* X1B = (bf16*)(F.ws + WS_Z) + (size_t)MPAD * DM;
    const float* gpost = first ? F.in[I_GPOSTMIX] : F.in[I_GPOSTMLP]; const float* gpre = F.in[I_GPREMLP];
    for (int m = MP + (NGW - 1 - gw); m < MPAD; m += NGW) {
        if (m >= MR) { if (first) { GAS v2u* o8 = (GAS v2u*)(V + (size_t)m * DM) + lane;
#pragma unroll
                for (int j = 0; j < 4; ++j) o8[64 * j] = (v2u){0u, 0u}; }
            continue; }
        const float* md = mod + mod_row(m) * 6144;
        f32x4 gg[4], gs2[4], sh2[4], v[4], bs[4];
#pragma unroll
        for (int j = 0; j < 4; ++j) { const int k = 4 * lane + 256 * j;
            gg[j] = *(const f32x4*)(gpost + k) * *(const f32x4*)(md + (first ? 2048 : 5120) + k);
            if (first) { gs2[j] = *(const f32x4*)(gpre + k) * (*(const f32x4*)(md + 4096 + k) + 1.0f); sh2[j] = *(const f32x4*)(md + 3072 + k); }
            else { gs2[j] = (f32x4){0.f, 0.f, 0.f, 0.f}; sh2[j] = gs2[j]; }
            v[j] = (f32x4){0.f, 0.f, 0.f, 0.f}; }
        for (int ks = 0; ks < nsl; ++ks) { const GAS f32x4* pr = (const GAS f32x4*)(slab + ((size_t)ks * 256 + (m - MP)) * DM) + lane;
#pragma unroll
            for (int j = 0; j < 4; ++j) v[j] += pr[64 * j]; }
        if (first) { const GAS f32x4* br = (const GAS f32x4*)x_row(F, m) + lane;
#pragma unroll
            for (int j = 0; j < 4; ++j) bs[j] = br[64 * j]; }
        else { const GAS v4u* x1r = (const GAS v4u*)(X1B + (size_t)m * DM) + lane;
#pragma unroll
            for (int jp = 0; jp < 2; ++jp) { const v4u t = x1r[64 * jp]; bs[2 * jp] = (f32x4){bf_lo(t.x), bf_hi(t.x), bf_lo(t.y), bf_hi(t.y)}; bs[2 * jp + 1] = (f32x4){bf_lo(t.z), bf_hi(t.z), bf_lo(t.w), bf_hi(t.w)}; } }
        post_row(v, bs, gg, gs2, sh2, first, X1B + (size_t)m * DM, V + (size_t)m * DM, F.out + (size_t)m * DM, lane);
    }
    for (int blk = gw; blk < MP / 16; blk += NGW) {
        const int m0 = blk * 16;
        const float* md = mod + mod_row(m0) * 6144;
        f32x4 gg[4], gs2[4], sh2[4];
#pragma unroll
        for (int j = 0; j < 4; ++j) { const int k = 4 * lane + 256 * j;
            gg[j] = *(const f32x4*)(gpost + k) * *(const f32x4*)(md + (first ? 2048 : 5120) + k);
            if (first) { gs2[j] = *(const f32x4*)(gpre + k) * (*(const f32x4*)(md + 4096 + k) + 1.0f); sh2[j] = *(const f32x4*)(md + 3072 + k); }
            else { gs2[j] = (f32x4){0.f, 0.f, 0.f, 0.f}; sh2[j] = gs2[j]; } }
        for (int r = 0; r < 16; r += 2) {
            f32x4 v[2][4], bs[2][4];
#pragma unroll
            for (int q = 0; q < 2; ++q) { const int m = m0 + r + q;
                { const GAS v4u* sr = (const GAS v4u*)(S + (size_t)m * DM) + lane;
                  const v4u t0 = sr[0], t1 = sr[64];
                  const int a0 = (lane >> 1) * 4, a1 = ((lane >> 1) + 32) * 4; const bool hi = (lane & 1) != 0;
#pragma unroll
                  for (int j = 0; j < 4; ++j) { const v4u t = (j >> 1) ? t1 : t0; const int ad = (j & 1) ? a1 : a0;
                      const unsigned gx = (unsigned)__builtin_amdgcn_ds_bpermute(ad, (int)t.x), gy = (unsigned)__builtin_amdgcn_ds_bpermute(ad, (int)t.y),
                                     gz = (unsigned)__builtin_amdgcn_ds_bpermute(ad, (int)t.z), gw = (unsigned)__builtin_amdgcn_ds_bpermute(ad, (int)t.w);
                      const unsigned u0 = hi ? gz : gx, u1 = hi ? gw : gy;
                      v[q][j] = (f32x4){bf_lo(u0), bf_hi(u0), bf_lo(u1), bf_hi(u1)}; } }
                if (first) { const GAS f32x4* br = (const GAS f32x4*)x_row(F, m) + lane;
#pragma unroll
                    for (int j = 0; j < 4; ++j) bs[q][j] = br[64 * j]; }
                else { const GAS v4u* x1r = (const GAS v4u*)(X1B + (size_t)m * DM) + lane;
#pragma unroll
                    for (int jp = 0; jp < 2; ++jp) { const v4u t = x1r[64 * jp]; bs[q][2 * jp] = (f32x4){bf_lo(t.x), bf_hi(t.x), bf_lo(t.y), bf_hi(t.y)}; bs[q][2 * jp + 1] = (f32x4){bf_lo(t.z), bf_hi(t.z), bf_lo(t.w), bf_hi(t.w)}; } } }
#pragma unroll
            for (int q = 0; q < 2; ++q) { const int m = m0 + r + q;
                post_row(v[q], bs[q], gg, gs2, sh2, first, X1B + (size_t)m * DM, V + (size_t)m * DM, F.out + (size_t)m * DM, lane); }
        }
    }
}

__device__ __forceinline__ void sample_mix_merge(const Frame& F, int j, pg8::bf16_t* MIX, const pg8::bf16_t* GS, const float* slab, unsigned* cnt) {
    if (F.tid == 0) {
        unsigned sp = 0; while (__hip_atomic_load(cnt, RLX_AGENT) < (unsigned)pg8::SAMPLE_ARRIVALS) { __builtin_amdgcn_s_sleep(2); if (++sp > (1u << 22)) break; }
        __builtin_amdgcn_fence(__ATOMIC_ACQUIRE, "agent");
        asm volatile("s_waitcnt vmcnt(0)" ::: "memory");
    }
    __syncthreads();
    const int row = 4 * j + (F.tid >> 7), col = (F.tid & 127) * 8;
    const float* S = slab + (size_t)row * DM + col;
    f32x4 v0 = (f32x4){0.f, 0.f, 0.f, 0.f}, v1 = v0;
#pragma unroll
    for (int k = 0; k < pg8::NSPLIT; ++k) { v0 += *(const f32x4*)(S + (size_t)k * 256 * DM); v1 += *(const f32x4*)(S + (size_t)k * 256 * DM + 4); }
    const v4u gw = *(const v4u*)(GS + (size_t)row * DIN + col);
    pg8::bf16_t* mp = MIX + (size_t)(MP + row) * DM + col; const v4u t = *(const v4u*)mp;
    v0[0] = v0[0] * bf_lo(gw.x) + bf_lo(t.x); v0[1] = v0[1] * bf_hi(gw.x) + bf_hi(t.x); v0[2] = v0[2] * bf_lo(gw.y) + bf_lo(t.y); v0[3] = v0[3] * bf_hi(gw.y) + bf_hi(t.y);
    v1[0] = v1[0] * bf_lo(gw.z) + bf_lo(t.z); v1[1] = v1[1] * bf_hi(gw.z) + bf_hi(t.z); v1[2] = v1[2] * bf_lo(gw.w) + bf_lo(t.w); v1[3] = v1[3] * bf_hi(gw.w) + bf_hi(t.w);
    *(v4u*)mp = (v4u){cvt_pk_bf16(v0[0], v0[1]), cvt_pk_bf16(v0[2], v0[3]), cvt_pk_bf16(v1[0], v1[1]), cvt_pk_bf16(v1[2], v1[3])};
}

constexpr int NPHASE = 14;
__global__ void __launch_bounds__(NWAVES * 64, 2) fwd_kernel(Args args) {
    extern __shared__ __attribute__((aligned(16))) unsigned char lds[];
    Frame F;
    F.lds = (LAS unsigned char*)lds;
    F.tid = threadIdx.x; F.lane = F.tid & 63; F.wave = __builtin_amdgcn_readfirstlane(F.tid >> 6);
    F.G = gridDim.x; F.bid = blockIdx.x;
    F.in = args.in; F.out = args.out; F.ws = args.ws;
    unsigned char* ws = args.ws;
    for (int u = F.tid; u < (LDS_BYTES - LDSCTL_OFF) / 4; u += NWAVES * 64) ((LAS unsigned*)(F.lds + LDSCTL_OFF))[u] = 0u;
    __syncthreads();
    const int lo = args.ph_lo, hi = args.ph_hi;
    const bool multi = (hi - lo) > 1;
    XcdBarrier bar; bar.bar = (unsigned*)(ws + WS_CTL) + CW_BAR; bar.x = 0; bar.st = nullptr;
    if (multi) bar = xcd_barrier_post((unsigned*)(ws + WS_CTL) + CW_BAR, (volatile LAS unsigned*)(F.lds + MISC_OFF) + 8);
#define IN(k) (lo <= (k) && (k) < hi)
#define SEAM(k) do { if (IN(k) && IN((k) + 1)) xcd_barrier(bar); } while (0)
    using namespace pg8;
    bf16_t* U = (bf16_t*)(ws + WS_U); bf16_t* Zb = (bf16_t*)(ws + WS_Z); bf16_t* XBC = (bf16_t*)(ws + WS_XBC); bf16_t* Pb = (bf16_t*)args.out;
    bf16_t* Gb = (bf16_t*)(ws + WS_G); bf16_t* PM = (bf16_t*)(ws + WS_PM); bf16_t* MIXIN = (bf16_t*)(ws + WS_MIXIN);
    float* MIXF = (float*)(ws + WS_Z); bf16_t* HDN = (bf16_t*)(ws + WS_XBC);
    bf16_t* WinT = (bf16_t*)(ws + WS_WIN);

    if (IN(0)) { p0_prologue(F); } SEAM(0);
    if (IN(1)) { p1_u(F); } SEAM(1);
    if (IN(2)) {
        Gemm g{U, WinT, MPAD, N1A, DM, DM, DM, 0}; InProjOrder S; S.init(F.G, F.bid);
        Epi1a E{Zb, XBC, Pb, (float*)(ws + WS_DT), F.in[I_DTB], args.out, (bf16_t*)(ws + WS_GS), (bf16_t*)(ws + WS_HALO)};
        gemm_phase<Epi1a, InProjOrder, true>(F.lds + RING_OFF, g, S, E);
    } SEAM(2);
    if (IN(3)) { p2b_conv_bc(F); } SEAM(3);
    if (IN(4)) { p3_ssd(F); } SEAM(4);
    if (IN(5)) { p4_norm_pool(F); }
    if (IN(6)) {
        Gemm g{U, WinT + (size_t)N1A * DM, MP, N1B, DM, DM, DM, 0}; StaticOrder S; S.init(MP, N1B, F.G, F.bid);
        EpiGateT E{Gb};
        gemm_phase<EpiGateT, StaticOrder, true>(F.lds + RING_OFF, g, S, E);
    } SEAM(6);
    if (IN(7)) {
        Gemm g{PM, (bf16_t*)(ws + WS_WPOOL), MPAD, DM, 256, DM, 256, 256}; StaticOrder S; S.init(MPAD, DM, F.G, F.bid);
        EpiGated<0> E{MIXIN, Gb, 1024, (const bf16_t*)(ws + WS_GS), (float*)(ws + WS_SLAB), (unsigned*)(ws + WS_CTL) + CW_SCNT, Pb};
        gemm_phase<EpiGated<0>, StaticOrder, true>(F.lds + RING_OFF, g, S, E);
    }
    if (IN(8)) {
        Gemm g{Zb, (bf16_t*)(ws + WS_WSSD), MPAD, DM, DIN, DIN, DIN, 0}; SplitOrder S; S.init(4, 4, NSPLIT, DIN / BK / NSPLIT, F.G, F.bid, 32);
        EpiGated<1> E{MIXIN, Gb, 0, (const bf16_t*)(ws + WS_GS), (float*)(ws + WS_SLAB), (unsigned*)(ws + WS_CTL) + CW_SCNT, Pb};
        gemm_phase<EpiGated<1>, SplitOrder, true>(F.lds + RING_OFF, g, S, E);
        if (F.bid >= 32 && F.bid < 64) sample_mix_merge(F, F.bid - 32, MIXIN, (const bf16_t*)(ws + WS_GS), (const float*)(ws + WS_SLAB), (unsigned*)(ws + WS_CTL) + CW_SCNT);
    } SEAM(8);
    if (IN(9)) {
        Gemm g{MIXIN, (bf16_t*)(ws + WS_WO), MPAD, DM, DM, DM, DM, 0}; SplitOrder S; S.init(4, 4, 4, 4, F.G, F.bid);
        EpiBf16S E{(bf16_t*)MIXF, DM, (float*)(ws + WS_SLAB)};
        gemm_phase<EpiBf16S, SplitOrder, true>(F.lds + RING_OFF, g, S, E);
    } SEAM(9);
    if (IN(10)) { p_post(F, (const bf16*)MIXF, true, (const float*)(ws + WS_SLAB), 4); } SEAM(10);
    if (IN(11)) {
        Gemm g{U, (bf16_t*)(ws + WS_WUP), MPAD, DFF, DM, DM, DM, 0}; StaticOrder S; S.init(MPAD, DFF, F.G, F.bid);
        EpiHdnT E{HDN};
        gemm_phase<EpiHdnT, StaticOrder, true>(F.lds + RING_OFF, g, S, E);
    } SEAM(11);
    if (IN(12)) {
        Gemm g{HDN, (bf16_t*)(ws + WS_WDOWN), MPAD, DM, DFF, DFF, DFF, 0}; SplitOrderRev S; S.init(4, 4, 8, 8, F.G, F.bid);
        EpiBf16S E{(bf16_t*)MIXF, DM, (float*)(ws + WS_SLAB)};
        gemm_phase<EpiBf16S, SplitOrderRev, true, true>(F.lds + RING_OFF, g, S, E);
    } SEAM(12);
    if (IN(13)) { p_post(F, (const bf16*)MIXF, false, (const float*)(ws + WS_SLAB), 8); }
#undef IN
#undef SEAM
}


#ifndef MK_PER_PHASE
#define MK_PER_PHASE 0
#endif
extern "C" void kernel_launch(void* const* d_in, const int* in_sizes, int n_in, void* d_out, int out_size, void* d_ws, size_t ws_size, hipStream_t stream) {
    static int grid = 0;
    if (grid == 0) {
        if (n_in != 26 || in_sizes[0] != MP * DM || out_size != 38322176 || ws_size < WS_END) {
            fprintf(stderr, "kernel_launch: unexpected shapes: n_in %d in0 %d out %d ws %zu (need %zu)\n", n_in, n_in > 0 ? in_sizes[0] : -1, out_size, ws_size, (size_t)WS_END); grid = -1; return; }
        int dev = 0, cus = 0, per_cu = 0;
        if (hipGetDevice(&dev) != hipSuccess || hipDeviceGetAttribute(&cus, hipDeviceAttributeMultiprocessorCount, dev) != hipSuccess) { grid = -1; return; }
        if (hipFuncSetAttribute((const void*)fwd_kernel, hipFuncAttributeMaxDynamicSharedMemorySize, LDS_BYTES) != hipSuccess) { fprintf(stderr, "kernel_launch: hipFuncSetAttribute failed\n"); grid = -1; return; }
        if (hipOccupancyMaxActiveBlocksPerMultiprocessor(&per_cu, (const void*)fwd_kernel, NWAVES * 64, LDS_BYTES) != hipSuccess || per_cu < 1) {
            fprintf(stderr, "kernel_launch: occupancy query reports %d blocks per CU\n", per_cu); }
        (void)hipGetLastError();
        grid = cus;
    }
    if (grid < 0) return;
    (void)hipMemsetAsync((char*)d_ws + WS_CTL, 0, CTL_ZERO_BYTES, stream);
    Args a{};
    for (int i = 0; i < 26; ++i) a.in[i] = (const float*)d_in[i];
    a.out = (float*)d_out; a.ws = (unsigned char*)d_ws;
#if MK_PER_PHASE
    for (int p = 0; p < NPHASE; ++p) { a.ph_lo = p; a.ph_hi = p + 1; hipLaunchKernelGGL(fwd_kernel, dim3(grid), dim3(NWAVES * 64), LDS_BYTES, stream, a); }
#else
    a.ph_lo = 0; a.ph_hi = NPHASE;
    hipLaunchKernelGGL(fwd_kernel, dim3(grid), dim3(NWAVES * 64), LDS_BYTES, stream, a);
#endif
}
```

```cpp
#include <hip/hip_runtime.h>
#include <cstdio>
#include <cstdint>

constexpr int DM = 1024, NBATCH = 8, SEQ = 4096, DSEQ = 16;
constexpr int MP = NBATCH * SEQ;
constexpr int MS = NBATCH * DSEQ;
constexpr int MR = MP + MS;
constexpr int MPAD = 33024;
constexpr int DIN = 2048, NHEAD = 32, DFF = 4096, CONVD = 4096;
constexpr int N1A = 7424, N1B = 2048;
constexpr float EPS = 1e-6f;
constexpr size_t OFF_SSM_P = 33685504, OFF_CONV_P = 35782656, OFF_POOL_P = 35880960, OFF_SSM_S = 36003840, OFF_CONV_S = 38100992, OFF_POOL_S = 38199296;

namespace pg8 {
#define PG8_LAS __attribute__((address_space(3)))
typedef unsigned short bf16_t;
typedef short bf16x8 __attribute__((ext_vector_type(8)));
typedef float f32x4 __attribute__((ext_vector_type(4)));
typedef unsigned u32x4 __attribute__((ext_vector_type(4)));
typedef unsigned u32x2 __attribute__((ext_vector_type(2)));
constexpr int BM = 256, BK = 64, HALF = 128, HTB = HALF * BK * 2, STAGE_BYTES = 8 * HTB, NXCD = 8, WGM = 8;

__host__ __device__ __forceinline__ int lds_byte(int r, int c) { const int st = (r >> 4) * 2 + (c >> 5), rr = r & 15, cc = c & 31, ob = rr * 64 + cc * 2; return st * 1024 + (ob ^ (((ob >> 9) & 1) << 5)); }
__host__ __device__ __forceinline__ void stage_rc(int b, int& R, int& C) { const int st = b / 1024, sb = b % 1024, swz = sb ^ (((sb >> 9) & 1) << 5); R = (st >> 1) * 16 + swz / 64; C = (st & 1) * 32 + (swz % 64) / 2; }
__host__ __device__ __forceinline__ int tile_vec(int R, int C) { return (((R >> 4) * 2 + (C >> 5)) * 16 + (R & 15)) * 4 + ((C >> 3) & 3); }
__host__ __device__ __forceinline__ int perm32(int rho) { const int n = rho >> 4, i = rho & 15; return 8 * (i >> 2) + 4 * n + (i & 3); }

struct Unit { int pm, pn, kofs, nk, hn; };
__host__ __device__ __forceinline__ bool unit_half(const Unit& u) { return u.pm == 128; }
struct Gemm { const bf16_t* A; const bf16_t* Bt; int M, N, K, lda, ldb, a_pn_off; };

struct StaticOrder {
    int nM, nN, nwg, G, c;
    __host__ __device__ void init(int M, int N, int G_, int c_) { nM = M / BM; nN = N / BM; nwg = nM * nN; G = G_; c = c_; }
    __host__ __device__ bool next(int i, Unit& u) const {
        const long L = (long)i * G + c; if (L >= nwg) return false;
        int wgid = (int)L; { const int q = nwg / NXCD, r = nwg % NXCD, xcd = wgid % NXCD, off = wgid / NXCD; wgid = (xcd < r ? xcd * (q + 1) : r * (q + 1) + (xcd - r) * q) + off; }
        const int nig = WGM * nN, gid = wgid / nig, fm = gid * WGM, gsz = (nM - fm) < WGM ? (nM - fm) : WGM;
        u.pm = fm + ((wgid % nig) % gsz); u.pn = (wgid % nig) / gsz; u.kofs = 0; u.nk = 0; u.hn = 0; return true;
    }
};
template <bool REV = false> struct SplitOrderT {
    StaticOrder P; int np, nNs, ksplit, nk, G, c, ofs;
    __host__ __device__ void init(int nNp, int nNs_, int ksplit_, int nk_, int G_, int c_, int ofs_ = 0) { P.init(MP, nNp * BM, G_, c_); np = P.nwg; nNs = nNs_; ksplit = ksplit_; nk = nk_; G = G_; c = c_; ofs = ofs_; }
    __host__ __device__ bool next(int i, Unit& u) const {
        const long L = (long)i * G + c;
        if (L < np) return P.next(REV ? np / G - 1 - i : i, u);
        const int idx = (int)(L - np) - ofs; if (idx < 0 || idx >= nNs * ksplit) return false;
        u.pm = 128; u.pn = idx % nNs; const int ks = idx / nNs; u.kofs = ks * nk * BK; u.nk = ksplit > 1 ? nk : 0; u.hn = 0; return true;
    }
};

typedef SplitOrderT<false> SplitOrder; typedef SplitOrderT<true> SplitOrderRev;
struct InProjOrder {
    StaticOrder P; int G, c;
    __host__ __device__ void init(int G_, int c_) { P.init(MP, 28 * BM, G_, c_); G = G_; c = c_; }
    __host__ __device__ bool next(int i, Unit& u) const {
        const long L = (long)i * G + c;
        if (L < P.nwg) return P.next(i, u);
        int idx = (int)(L - P.nwg); u.kofs = 0; u.nk = 0;
        if (idx < 128) { u.pm = idx; u.pn = 28; u.hn = 1; return true; }
        idx -= 128; if (idx >= 37) return false;
        u.pm = 128; u.pn = idx; u.hn = idx == 28 ? 1 : 0; return true;
    }
};

typedef __bf16 bf16x2_t __attribute__((ext_vector_type(2)));
typedef float f32x2_t __attribute__((ext_vector_type(2)));
__device__ __forceinline__ unsigned cvt_pk_bf16(float lo, float hi) { const f32x2_t v = {lo, hi}; const bf16x2_t b = __builtin_convertvector(v, bf16x2_t); return __builtin_bit_cast(unsigned, b); }
__device__ __forceinline__ float bf_lo(unsigned u) { return __uint_as_float(u << 16); }
__device__ __forceinline__ float bf_hi(unsigned u) { return __uint_as_float(u & 0xffff0000u); }
__device__ __forceinline__ float silu_f(float v) { return v * __builtin_amdgcn_rcpf(1.0f + __expf(-v)); }
__device__ __forceinline__ float sigmoid_f(float v) { return __builtin_amdgcn_rcpf(1.0f + __expf(-v)); }
__device__ __forceinline__ float softplus_f(float x) { const float e = __expf(x); return x > 20.f ? x : (e < 1e-4f ? e * (1.f - 0.5f * e) : __logf(1.f + e)); }
__device__ __forceinline__ u32x4 pack8(const f32x4 a, const f32x4 b) { u32x4 w; w.x = cvt_pk_bf16(a[0], a[1]); w.y = cvt_pk_bf16(a[2], a[3]); w.z = cvt_pk_bf16(b[0], b[1]); w.w = cvt_pk_bf16(b[2], b[3]); return w; }


struct Epi1a {
    static constexpr bool PERM = true, AFTER_DRAIN = false;
    bf16_t* Z; bf16_t* XBC; bf16_t* P; float* DT; const float* dt_bias; float* out; bf16_t* GS; bf16_t* HALO;
    __device__ __forceinline__ void operator()(const f32x4 (&acc)[2][2][4][2], const Unit& u, int wr, int wc, int fr, int fq) const {
        const int pn = u.pn, row0 = u.pm * BM + wr * 64 + fr, cl0 = wc * 32 + 8 * fq;
        if (pn >= 29) {
#pragma unroll
            for (int m = 0; m < 4; ++m) { const int rl = wr * 64 + fr + m * 16;
#pragma unroll
                for (int bj = 0; bj < 2; ++bj) { f32x4 v0 = acc[0][bj][m][0], v1 = acc[0][bj][m][1];
#pragma unroll
                    for (int i = 0; i < 4; ++i) { v0[i] = sigmoid_f(v0[i]); v1[i] = sigmoid_f(v1[i]); }
                    *(u32x4*)(GS + (size_t)rl * DIN + (pn - 29) * BM + bj * HALF + cl0) = pack8(v0, v1); } }
        } else if (pn < 8) {
#pragma unroll
            for (int ai = 0; ai < 2; ++ai)
#pragma unroll
                for (int m = 0; m < 4; ++m) { const int row = row0 + ai * HALF + m * 16;
#pragma unroll
                    for (int bj = 0; bj < 2; ++bj) { f32x4 v0 = acc[ai][bj][m][0], v1 = acc[ai][bj][m][1];
#pragma unroll
                        for (int i = 0; i < 4; ++i) { v0[i] = silu_f(v0[i]); v1[i] = silu_f(v1[i]); }
                        *(u32x4*)(Z + (size_t)row * DIN + pn * BM + bj * HALF + cl0) = pack8(v0, v1); } }
        } else if (pn < 24) {
#pragma unroll
            for (int ai = 0; ai < 2; ++ai)
#pragma unroll
                for (int m = 0; m < 4; ++m) { const int row = row0 + ai * HALF + m * 16;
                    long so = -1;
                    if (row < MP) { const int t = row & (SEQ - 1); if (t >= SEQ - 3) so = (long)OFF_CONV_P + ((long)(row >> 12) * 3 + (t - (SEQ - 3))) * CONVD; }
                    else if (row < MR) { const int rs = row - MP, t = rs & 15; if (t >= DSEQ - 3) so = (long)OFF_CONV_S + ((long)(rs >> 4) * 3 + (t - (DSEQ - 3))) * CONVD; }
                    long ho = -1;
                    if (pn >= 16 && row < MP) { const int t = row & (SEQ - 1); if ((t & 511) >= 509 && t < SEQ - 512) ho = ((long)((row >> 12) * 8 + (t >> 9) + 1) * 3 + ((t & 511) - 509)) * 2048 - 2048; }
#pragma unroll
                    for (int bj = 0; bj < 2; ++bj) { const f32x4 v0 = acc[ai][bj][m][0], v1 = acc[ai][bj][m][1]; const int col = (pn - 8) * BM + bj * HALF + cl0; const u32x4 pk = pack8(v0, v1);
                        *(u32x4*)(XBC + (size_t)row * CONVD + col) = pk;
                        if (ho >= 0) *(u32x4*)(HALO + ho + col) = pk;
                        if (so >= 0) { *(f32x4*)(out + so + col) = v0; *(f32x4*)(out + so + col + 4) = v1; } } }
        } else if (pn < 28) {
#pragma unroll
            for (int ai = 0; ai < 2; ++ai)
#pragma unroll
                for (int m = 0; m < 4; ++m) { const int row = row0 + ai * HALF + m * 16;
                    long so = -1;
                    if (row < MP) { const int t = row & (SEQ - 1); if (t >= SEQ - 15) so = (long)OFF_POOL_P + ((long)(row >> 12) * 15 + (t - (SEQ - 15))) * DM; }
                    else if (row < MR) { const int rs = row - MP, t = rs & 15; if (t >= 1) so = (long)OFF_POOL_S + ((long)(rs >> 4) * 15 + (t - 1)) * DM; }
#pragma unroll
                    for (int bj = 0; bj < 2; ++bj) { const f32x4 v0 = acc[ai][bj][m][0], v1 = acc[ai][bj][m][1]; const int col = (pn - 24) * BM + bj * HALF + cl0;
                        *(u32x4*)(P + (size_t)row * DM + col) = pack8(v0, v1);
                        if (so >= 0) { *(f32x4*)(out + so + col) = v0; *(f32x4*)(out + so + col + 4) = v1; } } }
        } else {
            const int dc = 8 * wc + 2 * fq; const float b0 = dt_bias[dc], b1 = dt_bias[dc + 1];
#pragma unroll
            for (int ai = 0; ai < 2; ++ai)
#pragma unroll
                for (int m = 0; m < 4; ++m) { const int row = row0 + ai * HALF + m * 16;
                    f32x2_t o; o.x = softplus_f(acc[ai][0][m][0][0] + b0); o.y = softplus_f(acc[ai][0][m][0][1] + b1);
                    *(f32x2_t*)(DT + (size_t)row * 32 + dc) = o; }
        }
    }
};
template <int ACT> struct EpiAct {
    static constexpr bool PERM = true, AFTER_DRAIN = false;
    bf16_t* O; int ldc;
    __device__ __forceinline__ void operator()(const f32x4 (&acc)[2][2][4][2], const Unit& u, int wr, int wc, int fr, int fq) const {
        const int row0 = u.pm * BM + wr * 64 + fr, col0 = u.pn * BM + wc * 32 + 8 * fq;
#pragma unroll
        for (int ai = 0; ai < 2; ++ai)
#pragma unroll
            for (int m = 0; m < 4; ++m) { bf16_t* rowp = O + (size_t)(row0 + ai * HALF + m * 16) * ldc + col0;
#pragma unroll
                for (int bj = 0; bj < 2; ++bj) { f32x4 v0 = acc[ai][bj][m][0], v1 = acc[ai][bj][m][1];
#pragma unroll
                    for (int i = 0; i < 4; ++i) {
                        if (ACT == 1) { v0[i] = sigmoid_f(v0[i]); v1[i] = sigmoid_f(v1[i]); }
                        if (ACT == 2) { const float a = fmaxf(v0[i], 0.f), b = fmaxf(v1[i], 0.f); v0[i] = a * a; v1[i] = b * b; } }
                    *(u32x4*)(rowp + bj * HALF) = pack8(v0, v1); } }
    }
};
struct EpiHdnT {
    static constexpr bool PERM = true, AFTER_DRAIN = false;
    bf16_t* O;
    __device__ __forceinline__ void operator()(const f32x4 (&acc)[2][2][4][2], const Unit& u, int wr, int wc, int fr, int fq) const {
        bf16_t* base = O + ((size_t)(u.pm * (DFF / BK) + u.pn * 4 + (wc >> 1)) * (BM * BK)) + (size_t)((((wr * 4) * 2 + (wc & 1)) * 16 + fr) * 4 + fq) * 8;
#pragma unroll
        for (int ai = 0; ai < 2; ++ai)
#pragma unroll
            for (int m = 0; m < 4; ++m)
#pragma unroll
                for (int bj = 0; bj < 2; ++bj) { f32x4 v0 = acc[ai][bj][m][0], v1 = acc[ai][bj][m][1];
#pragma unroll
                    for (int i = 0; i < 4; ++i) { const float a = fmaxf(v0[i], 0.f), b = fmaxf(v1[i], 0.f); v0[i] = a * a; v1[i] = b * b; }
                    *(u32x4*)(base + (size_t)(2 * bj) * (BM * BK) + (size_t)((ai * 8 + m) * 2 * 4 * 16) * 8) = pack8(v0, v1); }
    }
};
constexpr int NSPLIT = 8, SAMPLE_ARRIVALS = (4 + 4 * NSPLIT) * 8;
__device__ __forceinline__ size_t tiled_slot(int t, int wr, int wc, int fr, int fq) { return (size_t)t * 65536 + (size_t)(((wr * 4 + wc) * 64 + fq * 16 + fr) * 8); }
__device__ __forceinline__ void st16_sc1(void* p, const f32x4 v) { asm volatile("global_store_dwordx4 %0, %1, off sc1\n\ts_nop 1" :: "v"(p), "v"(v) : "memory"); }
__device__ __forceinline__ void st16_sc1(void* p, const u32x4 v) { asm volatile("global_store_dwordx4 %0, %1, off sc1\n\ts_nop 1" :: "v"(p), "v"(v) : "memory"); }
template <int MODE> struct EpiGated {
    static constexpr bool PERM = true, AFTER_DRAIN = false;
    bf16_t* MIX; const bf16_t* Gt; int goff; const bf16_t* GS; float* slab; unsigned* cnt; bf16_t* TT;
    __device__ __forceinline__ void operator()(const f32x4 (&acc)[2][2][4][2], const Unit& u, int wr, int wc, int fr, int fq) const {
        const int row0 = u.pm * BM + wr * 64 + fr, col0 = u.pn * BM + wc * 32 + 8 * fq;
        if (u.pm == 128) {
            int rl0 = wr * 64 + fr; asm volatile("" : "+v"(rl0));
            if (MODE == 0) {
#pragma unroll
                for (int m = 0; m < 4; ++m)
#pragma unroll
                    for (int bj = 0; bj < 2; ++bj) { f32x4 v0 = acc[0][bj][m][0], v1 = acc[0][bj][m][1];
                        const u32x4 gw = *(const u32x4*)(GS + (size_t)(rl0 + m * 16) * DIN + goff + col0 + bj * HALF);
                        v0[0] *= bf_lo(gw.x); v0[1] *= bf_hi(gw.x); v0[2] *= bf_lo(gw.y); v0[3] *= bf_hi(gw.y);
                        v1[0] *= bf_lo(gw.z); v1[1] *= bf_hi(gw.z); v1[2] *= bf_lo(gw.w); v1[3] *= bf_hi(gw.w);
                        st16_sc1(MIX + (size_t)(MP + rl0 + m * 16) * DM + col0 + bj * HALF, pack8(v0, v1)); }
            } else {
                float* S = slab + (size_t)(u.kofs / (u.nk * BK)) * 256 * DM + (size_t)rl0 * DM + col0;
#pragma unroll
                for (int m = 0; m < 4; ++m)
#pragma unroll
                    for (int bj = 0; bj < 2; ++bj) { st16_sc1(S + (size_t)(m * 16) * DM + bj * HALF, acc[0][bj][m][0]); st16_sc1(S + (size_t)(m * 16) * DM + bj * HALF + 4, acc[0][bj][m][1]); }
            }
            asm volatile("s_waitcnt vmcnt(0)" ::: "memory");
            if ((threadIdx.x & 63) == 0) (void)__hip_atomic_fetch_add(cnt, 1u, __ATOMIC_RELAXED, __HIP_MEMORY_SCOPE_AGENT);
            return;
        }
        const bf16_t* gp = Gt + tiled_slot(u.pm * 8 + (MODE == 0 ? 4 : 0) + u.pn, wr, wc, fr, fq); bf16_t* tp = TT + tiled_slot(u.pm * 4 + u.pn, wr, wc, fr, fq);
#pragma unroll
        for (int ai = 0; ai < 2; ++ai)
#pragma unroll
            for (int m = 0; m < 4; ++m) { const size_t row = (size_t)(row0 + ai * HALF + m * 16);
#pragma unroll
                for (int bj = 0; bj < 2; ++bj) { f32x4 v0 = acc[ai][bj][m][0], v1 = acc[ai][bj][m][1]; const int sl = ((ai * 4 + m) * 2 + bj) * 4096;
                    const u32x4 gw = *(const u32x4*)(gp + sl);
                    v0[0] *= bf_lo(gw.x); v0[1] *= bf_hi(gw.x); v0[2] *= bf_lo(gw.y); v0[3] *= bf_hi(gw.y);
                    v1[0] *= bf_lo(gw.z); v1[1] *= bf_hi(gw.z); v1[2] *= bf_lo(gw.w); v1[3] *= bf_hi(gw.w);
                    if (MODE == 0) *(u32x4*)(tp + sl) = pack8(v0, v1);
                    else { const u32x4 t = *(const u32x4*)(tp + sl);
                        v0[0] += bf_lo(t.x); v0[1] += bf_hi(t.x); v0[2] += bf_lo(t.y); v0[3] += bf_hi(t.y);
                        v1[0] += bf_lo(t.z); v1[1] += bf_hi(t.z); v1[2] += bf_lo(t.w); v1[3] += bf_hi(t.w);
                        *(u32x4*)(MIX + row * DM + col0 + bj * HALF) = pack8(v0, v1); } } }
    }
};
struct EpiGateT {
    static constexpr bool PERM = true, AFTER_DRAIN = false;
    bf16_t* G;
    __device__ __forceinline__ void operator()(const f32x4 (&acc)[2][2][4][2], const Unit& u, int wr, int wc, int fr, int fq) const {
        bf16_t* gp = G + tiled_slot(u.pm * 8 + u.pn, wr, wc, fr, fq);
#pragma unroll
        for (int ai = 0; ai < 2; ++ai)
#pragma unroll
            for (int m = 0; m < 4; ++m)
#pragma unroll
                for (int bj = 0; bj < 2; ++bj) { f32x4 v0 = acc[ai][bj][m][0], v1 = acc[ai][bj][m][1];
#pragma unroll
                    for (int i = 0; i < 4; ++i) { v0[i] = sigmoid_f(v0[i]); v1[i] = sigmoid_f(v1[i]); }
                    *(u32x4*)(gp + ((ai * 4 + m) * 2 + bj) * 4096) = pack8(v0, v1); }
    }
};
struct EpiBf16S {
    static constexpr bool PERM = true, AFTER_DRAIN = false;
    bf16_t* O; int ldc; float* slab;
    __device__ __forceinline__ void operator()(const f32x4 (&acc)[2][2][4][2], const Unit& u, int wr, int wc, int fr, int fq) const {
        if (u.nk) {
            float* S = slab + (size_t)(u.kofs / (u.nk * BK)) * 256 * ldc + (size_t)(wr * 64 + fr) * ldc + u.pn * BM + wc * 32 + 8 * fq;
#pragma unroll
            for (int m = 0; m < 4; ++m)
#pragma unroll
                for (int bj = 0; bj < 2; ++bj) { *(f32x4*)(S + (size_t)(m * 16) * ldc + bj * HALF) = acc[0][bj][m][0]; *(f32x4*)(S + (size_t)(m * 16) * ldc + bj * HALF + 4) = acc[0][bj][m][1]; }
            return; }
        const int row0 = u.pm * BM + wr * 64 + fr, col0 = u.pn * BM + wc * 32 + 8 * fq;
#pragma unroll
        for (int ai = 0; ai < 2; ++ai)
#pragma unroll
            for (int m = 0; m < 4; ++m) { bf16_t* rowp = O + (size_t)(row0 + ai * HALF + m * 16) * ldc + col0;
#pragma unroll
                for (int bj = 0; bj < 2; ++bj) *(u32x4*)(rowp + bj * HALF) = pack8(acc[ai][bj][m][0], acc[ai][bj][m][1]); }
    }
};
struct EpiF32 {
    static constexpr bool PERM = false, AFTER_DRAIN = false;
    float* C; int ldc; float* slab;
    __device__ __forceinline__ void operator()(const f32x4 (&acc)[2][2][4][2], const Unit& u, int wr, int wc, int fr, int fq) const {
        if (u.nk) {
            float* S = slab + (size_t)(u.kofs / (u.nk * BK)) * 256 * ldc + (size_t)(wr * 64 + fr) * ldc + u.pn * BM + wc * 32 + 4 * fq;
#pragma unroll
            for (int m = 0; m < 4; ++m)
#pragma unroll
                for (int bj = 0; bj < 2; ++bj)
#pragma unroll
                    for (int n = 0; n < 2; ++n) *(f32x4*)(S + (size_t)(m * 16) * ldc + bj * HALF + n * 16) = acc[0][bj][m][n];
            return; }
        const int row0 = u.pm * BM + wr * 64 + fr, col0 = u.pn * BM + wc * 32 + 4 * fq;
#pragma unroll
        for (int ai = 0; ai < 2; ++ai)
#pragma unroll
            for (int m = 0; m < 4; ++m) { float* rowp = C + (size_t)(row0 + ai * HALF + m * 16) * ldc + col0;
#pragma unroll
                for (int bj = 0; bj < 2; ++bj)
#pragma unroll
                    for (int n = 0; n < 2; ++n) *(f32x4*)(rowp + bj * HALF + n * 16) = acc[ai][bj][m][n]; }
    }
};

template <class Epi, class Sched, bool ALIGN_EPI, bool ATILED = false>
__device__ __forceinline__ void gemm_phase(PG8_LAS unsigned char* lds, const Gemm g, const Sched& S, const Epi& E) {
    const int tid = threadIdx.x, wid = __builtin_amdgcn_readfirstlane(tid >> 6), lane = tid & 63, wr = wid >> 2, wc = wid & 3, fr = lane & 15, fq = lane >> 4;
    const int K = g.K;
    unsigned voffA[2], voffB[2];
#pragma unroll
    for (int i = 0; i < 2; ++i) { int R, C; stage_rc(tid * 16 + i * 8192, R, C); const int Rb = Epi::PERM ? ((R & ~31) + perm32(R & 31)) : R;
        voffA[i] = ATILED ? (unsigned)(tile_vec(R, C) * 16) : (unsigned)(R * g.lda + C) * 2u; voffB[i] = (unsigned)(tile_vec(R, C) * 16); (void)Rb; }
    const size_t kstep = (size_t)(BM * BK * 2)  , kstepA = ATILED ? (size_t)(BM * BK * 2) : (size_t)(BK * 2);
    const size_t hstepA = ATILED ? (size_t)(HALF * BK * 2) : (size_t)HALF * g.lda * 2, hstepB = (size_t)(HALF * BK * 2);
    const size_t tstepA = ATILED ? (size_t)(g.K / BK) * (size_t)(BM * BK * 2) : 2 * hstepA, tstepB = (size_t)(g.ldb / BK) * (size_t)(BM * BK * 2), pnA = (size_t)g.a_pn_off * 2;
#define PG8_KOFSB(u) ((size_t)((u).kofs / BK) * (size_t)(BM * BK * 2))
#define PG8_KOFSA(u) (ATILED ? (size_t)((u).kofs / BK) * (size_t)(BM * BK * 2) : (size_t)(u).kofs * 2)
    const unsigned ldsw = (unsigned)wid * 1024u;
    const int aoff = lds_byte(wr * 64 + fr, fq * 8), boff = lds_byte(wc * 32 + fr, fq * 8);
#define PG8_SA(b, h) (((b) * 2 + (h)) * HTB)
#define PG8_SB(b, h) ((4 + (b) * 2 + (h)) * HTB)
#define PG8_STAGE(bufoff, gbase, voff) do { _Pragma("unroll") for (int _i = 0; _i < 2; ++_i) \
        __builtin_amdgcn_global_load_lds((const unsigned*)((const char*)(gbase) + (voff)[_i]), (PG8_LAS unsigned*)(lds + (bufoff) + ldsw + _i * 8192), 16, 0, 0); } while (0)
#define PG8_LDA(dst, b, h) do { _Pragma("unroll") for (int m = 0; m < 4; ++m) _Pragma("unroll") for (int k = 0; k < 2; ++k) dst[m][k] = *(const PG8_LAS bf16x8*)(lds + PG8_SA(b, h) + aoff + m * 2048 + k * 1024); } while (0)
#define PG8_LDB(dst, b, h) do { _Pragma("unroll") for (int n = 0; n < 2; ++n) _Pragma("unroll") for (int k = 0; k < 2; ++k) dst[n][k] = *(const PG8_LAS bf16x8*)(lds + PG8_SB(b, h) + boff + n * 2048 + k * 1024); } while (0)
#define PG8_MMA(ai, bj, At, Bt) do { __builtin_amdgcn_s_setprio(1); _Pragma("unroll") for (int m = 0; m < 4; ++m) _Pragma("unroll") for (int n = 0; n < 2; ++n) _Pragma("unroll") for (int k = 0; k < 2; ++k) \
        acc[ai][bj][m][n] = __builtin_amdgcn_mfma_f32_16x16x32_bf16(Bt[n][k], At[m][k], acc[ai][bj][m][n], 0, 0, 0); __builtin_amdgcn_s_setprio(0); } while (0)
#define PG8_WAIT_V(n) asm volatile("s_waitcnt vmcnt(" #n ")" ::: "memory")
#define PG8_WAIT_L(n) asm volatile("s_waitcnt lgkmcnt(" #n ")" ::: "memory")
#define PG8_BAR __builtin_amdgcn_s_barrier()
#define PG8_SCHED __builtin_amdgcn_sched_barrier(0)
    Unit cur, nxt; int ui = 0;
    if (!S.next(0, cur)) return;
    f32x4 acc[2][2][4][2];
#pragma unroll
    for (int a = 0; a < 2; ++a)
#pragma unroll
        for (int b = 0; b < 2; ++b)
#pragma unroll
            for (int m = 0; m < 4; ++m)
#pragma unroll
                for (int n = 0; n < 2; ++n) acc[a][b][m][n] = (f32x4){0.f, 0.f, 0.f, 0.f};
    bf16x8 At[4][2], B0[2][2], B1[2][2];
    const char* cA = (const char*)g.A + (size_t)cur.pm * tstepA + (size_t)cur.pn * pnA + PG8_KOFSA(cur); const char* cB = (const char*)g.Bt + (size_t)cur.pn * tstepB + PG8_KOFSB(cur);
    PG8_STAGE(PG8_SB(0, 0), cB, voffB); PG8_STAGE(PG8_SB(0, 1), cB + hstepB, voffB); PG8_STAGE(PG8_SA(0, 0), cA, voffA); PG8_STAGE(PG8_SA(0, 1), cA + hstepA, voffA);
    if (wr == 1) PG8_BAR;
    PG8_WAIT_V(2); PG8_BAR;
    PG8_STAGE(PG8_SB(1, 0), cB + kstep, voffB); PG8_STAGE(PG8_SA(1, 0), cA + kstepA, voffA); PG8_STAGE(PG8_SB(1, 1), cB + hstepB + kstep, voffB);
    PG8_WAIT_V(6); PG8_BAR;
    for (;;) {
        const bool has_next = S.next(ui + 1, nxt);
        const bool half = unit_half(cur);
        const bool halfn = cur.hn != 0;
        const char* nA = has_next ? (const char*)g.A + (size_t)nxt.pm * tstepA + (size_t)nxt.pn * pnA + PG8_KOFSA(nxt) : cA; const char* nB = has_next ? (const char*)g.Bt + (size_t)nxt.pn * tstepB + PG8_KOFSB(nxt) : cB;
        const int nt = cur.nk ? cur.nk : K / BK;
        for (int t = 0; t < nt; t += 2) {
            const bool last = (t == nt - 2);
            const char* a1 = cA + (size_t)(t + 1) * kstepA;
            const char* a2 = last ? nA : cA + (size_t)(t + 2) * kstepA; const char* b2 = last ? nB : cB + (size_t)(t + 2) * kstep;
            const char* a3 = a2 + kstepA; const char* b3 = b2 + kstep;
            PG8_LDB(B0, 0, 0); PG8_LDB(B1, 0, 1); PG8_SCHED; PG8_LDA(At, 0, 0); PG8_STAGE(PG8_SA(1, 1), a1 + hstepA, voffA);
            PG8_WAIT_V(8); PG8_WAIT_L(0); PG8_BAR; PG8_MMA(0, 0, At, B0); if (!halfn) PG8_MMA(0, 1, At, B1); PG8_BAR; PG8_SCHED;
            if (!half) PG8_LDA(At, 0, 1); PG8_STAGE(PG8_SB(0, 0), b2, voffB); PG8_STAGE(PG8_SB(0, 1), b2 + hstepB, voffB); PG8_STAGE(PG8_SA(0, 0), a2, voffA);
            PG8_WAIT_V(8); PG8_WAIT_L(0); PG8_BAR; if (!half) { PG8_MMA(1, 0, At, B0); if (!halfn) PG8_MMA(1, 1, At, B1); } PG8_BAR; PG8_SCHED;
            PG8_LDB(B0, 1, 0); PG8_LDB(B1, 1, 1); PG8_SCHED; PG8_LDA(At, 1, 0); PG8_STAGE(PG8_SA(0, 1), a2 + hstepA, voffA);
            PG8_WAIT_V(8); PG8_WAIT_L(0); PG8_BAR; PG8_MMA(0, 0, At, B0); if (!halfn) PG8_MMA(0, 1, At, B1); PG8_BAR; PG8_SCHED;
            if (!half) PG8_LDA(At, 1, 1); PG8_STAGE(PG8_SB(1, 0), b3, voffB); PG8_STAGE(PG8_SB(1, 1), b3 + hstepB, voffB); PG8_STAGE(PG8_SA(1, 0), a3, voffA);
            PG8_WAIT_V(8); PG8_WAIT_L(0); PG8_BAR; if (!half) { PG8_MMA(1, 0, At, B0); if (!halfn) PG8_MMA(1, 1, At, B1); } PG8_BAR; PG8_SCHED;
        }
        if constexpr (ALIGN_EPI) { if (wr == 0) PG8_BAR; }
        E(acc, cur, wr, wc, fr, fq);
        if (!has_next) break;
#pragma unroll
        for (int a = 0; a < 2; ++a)
#pragma unroll
            for (int b = 0; b < 2; ++b)
#pragma unroll
                for (int m = 0; m < 4; ++m)
#pragma unroll
                    for (int n = 0; n < 2; ++n) acc[a][b][m][n] = (f32x4){0.f, 0.f, 0.f, 0.f};
        cur = nxt; cA = nA; cB = nB; ++ui;
        if constexpr (ALIGN_EPI) { if (wr == 1) PG8_BAR; }
    }
    PG8_WAIT_V(0);
    if constexpr (!ALIGN_EPI) { if (wr == 0) PG8_BAR; }
    PG8_BAR;
#undef PG8_SA
#undef PG8_KOFSA
#undef PG8_KOFSB
#undef PG8_SB
#undef PG8_STAGE
#undef PG8_LDA
#undef PG8_LDB
#undef PG8_MMA
#undef PG8_WAIT_V
#undef PG8_WAIT_L
#undef PG8_BAR
#undef PG8_SCHED
}
}

constexpr int NWAVES = 8;
constexpr size_t MiB = 1u << 20;
constexpr size_t WS_CTL = 0, CTL_ZERO_BYTES = 64 * 1024;
constexpr size_t WS_MOD = 1 * MiB;
constexpr size_t WS_WIN = 2 * MiB;
constexpr size_t WS_WSSD = 21 * MiB;
constexpr size_t WS_WPOOL = 25 * MiB;
constexpr size_t WS_WO = 26 * MiB;
constexpr size_t WS_WUP = 28 * MiB;
constexpr size_t WS_WDOWN = 36 * MiB;
constexpr size_t WS_DT = 44 * MiB;
constexpr size_t WS_HALO = 48 * MiB + 128 * 1024;
constexpr size_t WS_SSQ = 49 * MiB;
constexpr size_t WS_GS = 49 * MiB;
constexpr size_t WS_SLAB = 50 * MiB;
constexpr size_t WS_U = 58 * MiB;
constexpr size_t WS_Z = 123 * MiB;
constexpr size_t WS_XBC = 252 * MiB;
constexpr size_t WS_G = WS_XBC;
constexpr size_t WS_PM = WS_G + (size_t)MPAD * 2048 * 2;
constexpr size_t WS_MIXIN = WS_PM + (size_t)MPAD * 1024 * 2;
constexpr size_t WS_END = WS_XBC + (size_t)MPAD * 4096 * 2;
static_assert(WS_MIXIN + (size_t)MPAD * 1024 * 2 <= WS_END, "ws map");
static_assert(WS_U + (size_t)MPAD * 1024 * 2 <= WS_Z && WS_Z + (size_t)MPAD * 2048 * 2 <= WS_XBC && WS_SSQ + (size_t)MPAD * 64 * 4 <= WS_U && WS_DT + (size_t)MPAD * 32 * 4 <= WS_SSQ, "ws map");
constexpr int CW_BAR = 4096, CW_SCNT = 8192;

constexpr int RING_OFF = 0, RING_BYTES = 131072;
constexpr int LDSCTL_OFF = RING_BYTES, MISC_OFF = LDSCTL_OFF + 320;
constexpr int LDS_BYTES = 147456;

#define GAS __attribute__((address_space(1)))
#define LAS __attribute__((address_space(3)))
typedef unsigned short bf16;
typedef unsigned v4u __attribute__((ext_vector_type(4)));
typedef unsigned v2u __attribute__((ext_vector_type(2)));
typedef float f32x4 __attribute__((ext_vector_type(4)));
typedef short bf16x8 __attribute__((ext_vector_type(8)));
typedef GAS unsigned gu32;
#define RLX_AGENT __ATOMIC_RELAXED, __HIP_MEMORY_SCOPE_AGENT
#define LDS_WAIT() asm volatile("s_waitcnt lgkmcnt(0)" ::: "memory")
using pg8::cvt_pk_bf16; using pg8::bf_lo; using pg8::bf_hi; using pg8::silu_f;

#define XB_TMO      128
#define XB_XCNT(j)  (256  + 64 * (j))
#define XB_XSUB(j)  (1280 + 64 * (j))
#define XB_XGEN(j)  (2304 + 64 * (j))
#define XB_TOP      3328
#define XB_TOPGEN   3392
#define XCD_BAR_WORDS 3456
#define XB_SPIN_CAP (1u << 18)
__device__ __forceinline__ unsigned xb_ld(unsigned* p)              { return __hip_atomic_load(p, __ATOMIC_RELAXED, __HIP_MEMORY_SCOPE_AGENT); }
__device__ __forceinline__ unsigned xb_add(unsigned* p, unsigned v) { return __hip_atomic_fetch_add(p, v, __ATOMIC_RELAXED, __HIP_MEMORY_SCOPE_AGENT); }
__device__ __forceinline__ unsigned xb_xcc_id() { return (unsigned)__builtin_amdgcn_s_getreg((3 << 11) | 20) & 0xFu; }
#define XB_SPIN(cond, bar) do { unsigned _sp = 0; while (cond) { __builtin_amdgcn_s_sleep(1); \
    if ((++_sp & 255u) == 0u) { if (xb_ld(&(bar)[XB_TMO])) break; if (_sp > XB_SPIN_CAP) { atomicAdd(&(bar)[XB_TMO], 1u); break; } } } } while (0)
struct XcdBarrier { unsigned* bar; unsigned x; volatile LAS unsigned* st; };
__device__ __forceinline__ XcdBarrier xcd_barrier_post(unsigned* bar, volatile LAS unsigned* st) {
    XcdBarrier b; b.bar = bar; b.x = xb_xcc_id(); b.st = st;
    if (threadIdx.x == 0) (void)xb_add(&bar[XB_XCNT(b.x)], 1u);
    return b;
}
__device__ __forceinline__ void xcd_barrier_complete(unsigned* bar, unsigned x, unsigned& nloc, unsigned& nx) {
    const unsigned G = gridDim.x * gridDim.y * gridDim.z;
    unsigned sum, cnt, mine, sp = 0u;
    for (;;) {
        sum = 0u; cnt = 0u; mine = 0u;
#pragma unroll
        for (unsigned j = 0; j < 16; ++j) { const unsigned c = xb_ld(&bar[XB_XCNT(j)]); sum += c; cnt += (c > 0u) ? 1u : 0u; mine = (j == x) ? c : mine; }
        if (sum == G) break;
        __builtin_amdgcn_s_sleep(1);
        if ((++sp & 255u) == 0u) { if (xb_ld(&bar[XB_TMO])) break; if (sp > XB_SPIN_CAP) { atomicAdd(&bar[XB_TMO], 1u); break; } }
    }
    nloc = mine > 0u ? mine : 1u; nx = cnt > 0u ? cnt : 1u;
}
__device__ __forceinline__ void xcd_barrier(const XcdBarrier& b) {
    asm volatile("s_waitcnt vmcnt(0)" ::: "memory");
    __syncthreads();
    if (threadIdx.x == 0) {
        unsigned* bar = b.bar;
        __builtin_amdgcn_s_waitcnt(0);
        unsigned nloc = b.st[0], nx = b.st[1];
        if (nloc == 0u) { xcd_barrier_complete(bar, b.x, nloc, nx); b.st[0] = nloc; b.st[1] = nx; }
        const unsigned old = xb_add(&bar[XB_XSUB(b.x)], 1u);
        const unsigned gen = old / nloc;
        if (old + 1u == (gen + 1u) * nloc) {
            __builtin_amdgcn_fence(__ATOMIC_RELEASE, "agent");
            asm volatile("s_waitcnt vmcnt(0)" ::: "memory");
            const unsigned og = xb_add(&bar[XB_TOP], 1u);
            const unsigned tg = og / nx;
            if (og + 1u == (tg + 1u) * nx) xb_add(&bar[XB_TOPGEN], 1u);
            else XB_SPIN(xb_ld(&bar[XB_TOPGEN]) == tg, bar);
            xb_add(&bar[XB_XGEN(b.x)], 1u);
            __builtin_amdgcn_fence(__ATOMIC_ACQUIRE, "agent");
            asm volatile("s_waitcnt vmcnt(0)" ::: "memory");
        } else {
            XB_SPIN(xb_ld(&bar[XB_XGEN(b.x)]) == gen, bar);
            __builtin_amdgcn_fence(__ATOMIC_ACQUIRE, "agent");
            asm volatile("s_waitcnt vmcnt(0)" ::: "memory");
        }
    }
    __syncthreads();
}

struct Args { const float* in[26]; float* out; unsigned char* ws; int ph_lo, ph_hi; };
struct Frame {
    LAS unsigned char* lds;
    int tid, lane, wave, G, bid;
    const float* const* in; float* out; unsigned char* ws;
};
enum { I_XP = 0, I_XS, I_SSM, I_CONV, I_POOL, I_CP, I_CS, I_WADA, I_BADA, I_GPREMIX, I_GPOSTMIX, I_GPREMLP, I_GPOSTMLP, I_WIN, I_CONVW, I_CONVB, I_DTB, I_ALOG, I_DSKIP, I_GSSD,
       I_WSSD, I_WPOOL, I_PSCALE, I_WO, I_WUP, I_WDOWN };

__device__ __forceinline__ float wave_sum(float v) {
#pragma unroll
    for (int o = 1; o < 64; o <<= 1) v += __shfl_xor(v, o);
    return v;
}

__device__ __forceinline__ void p0_transpose_item(const float* W, int ldw, int c0, int k0, bf16* WT, int drow0, int ldk, const float* rs, const float* cs, LAS float* scr, int lane) {
    float tv[32];
#pragma unroll
    for (int i = 0; i < 32; ++i) tv[i] = W[(size_t)(k0 + 2 * i + (lane >> 5)) * ldw + c0 + (lane & 31)];
#pragma unroll
    for (int i = 0; i < 32; ++i) { const int kk = 2 * i + (lane >> 5); float v = tv[i];
        if (rs) v *= rs[k0 + kk]; if (cs) v *= cs[c0 + (lane & 31)]; scr[kk * 33 + (lane & 31)] = v; }
    LDS_WAIT(); asm volatile("" ::: "memory");
    const int c = lane & 7;
#pragma unroll
    for (int j = 0; j < 4; ++j) { const int n = (lane >> 3) + 8 * j; const LAS float* s = scr + (8 * c) * 33 + n;
        v4u o; o.x = cvt_pk_bf16(s[0 * 33], s[1 * 33]); o.y = cvt_pk_bf16(s[2 * 33], s[3 * 33]); o.z = cvt_pk_bf16(s[4 * 33], s[5 * 33]); o.w = cvt_pk_bf16(s[6 * 33], s[7 * 33]);
        const int nd = drow0 == 7168 ? 32 * (n >> 3) + 8 * ((n & 7) >> 1) + (n & 1) : n;
        { const int row = drow0 + nd, nl = row & 255, c32 = nl & 31, slot = (nl & ~31) + 16 * ((c32 >> 2) & 1) + 4 * (c32 >> 3) + (c32 & 3);
          *(GAS v4u*)(WT + ((size_t)((row >> 8) * (ldk / 64) + (k0 >> 6)) * 2048 + pg8::tile_vec(slot, 8 * c)) * 8) = o; } }
    LDS_WAIT(); asm volatile("" ::: "memory");
}
struct TSeg { const float* W; int ldw, c0, ncols, K; bf16* WT; int drow0; const float* rs; const float* cs; };
__device__ __forceinline__ bool p0_seg(const TSeg& s, int& r, LAS float* scr, int lane) {
    const int nblk = s.ncols / 32, items = (s.K / 64) * nblk;
    if (r < items) { const int kb = r / nblk, nb = r % nblk; p0_transpose_item(s.W, s.ldw, s.c0 + 32 * nb, 64 * kb, s.WT, s.drow0 + 32 * nb, s.K, s.rs, s.cs, scr, lane); return true; }
    r -= items; return false;
}
__device__ __forceinline__ void p0_prologue(Frame& F) {
    unsigned char* ws = F.ws;
    bf16* WinT = (bf16*)(ws + WS_WIN);
    const int gw = F.bid * NWAVES + F.wave, NGW = F.G * NWAVES;
    if (F.bid < 96) {
        LAS float* sl = (LAS float*)(F.lds);
        LAS float* red = (LAS float*)(F.lds + 65536);
        { float cv[32];
#pragma unroll
          for (int j = 0; j < 32; ++j) { const int r = j >> 1, k = F.tid + 512 * (j & 1); cv[j] = r < 8 ? F.in[I_CP][r * DM + k] : F.in[I_CS][(r - 8) * DM + k]; }
#pragma unroll
          for (int j = 0; j < 32; ++j) { const int r = j >> 1, k = F.tid + 512 * (j & 1); sl[k * 16 + r] = silu_f(cv[j]); } }
        __syncthreads();
        const int n0 = F.bid * 64; const float* wa = F.in[I_WADA] + n0 + F.lane;
        float acc[16];
#pragma unroll
        for (int r = 0; r < 16; ++r) acc[r] = 0.f;
        const int kb = F.wave * 128;
        for (int k0 = 0; k0 < 128; k0 += 32) {
            float wv[32];
#pragma unroll
            for (int i = 0; i < 32; ++i) wv[i] = wa[(size_t)(kb + k0 + i) * 6144];
#pragma unroll
            for (int i = 0; i < 32; ++i) { const LAS f32x4* sp = (const LAS f32x4*)(sl + (kb + k0 + i) * 16);
#pragma unroll
                for (int r4 = 0; r4 < 4; ++r4) { const f32x4 s = sp[r4]; acc[4 * r4 + 0] += s[0] * wv[i]; acc[4 * r4 + 1] += s[1] * wv[i]; acc[4 * r4 + 2] += s[2] * wv[i]; acc[4 * r4 + 3] += s[3] * wv[i]; } } }
#pragma unroll
        for (int r = 0; r < 16; ++r) red[(F.wave * 16 + r) * 64 + F.lane] = acc[r];
        __syncthreads();
        float* mod = (float*)(ws + WS_MOD);
        for (int i = F.tid; i < 16 * 64; i += NWAVES * 64) { const int r = i >> 6, c = i & 63; float s = F.in[I_BADA][n0 + c];
#pragma unroll
            for (int w = 0; w < 8; ++w) s += red[(w * 16 + r) * 64 + c];
            mod[r * 6144 + n0 + c] = s; }
        __syncthreads();
    }
    LAS float* scr = (LAS float*)(F.lds + RING_OFF + F.wave * 16384);
    const float* w_in = F.in[I_WIN];
    constexpr int NITEMS = 16 * (192 + 32 + 1 + 64) + 32 * 32 + 4 * 4 * 8 + 16 * 32 + 16 * 128 + 64 * 32;
#define P0_SEG(W, ldw, c0, ncols, K, WT, drow0, rs, cs) { const TSeg sg{W, ldw, c0, ncols, K, WT, drow0, rs, cs}; if (p0_seg(sg, r, scr, F.lane)) continue; }
    const int nmodw = (F.G > 96 ? 96 : F.G) * NWAVES, nslots = nmodw + 2 * (NGW - nmodw);
    for (int pass = 0; pass < 2; ++pass) {
      if (pass == 1 && gw < nmodw) break;
      const int slot = gw < nmodw ? gw : nmodw + pass * (NGW - nmodw) + (gw - nmodw);
      for (int it = slot; it < NITEMS; it += nslots) {
        int r = it;
        P0_SEG(w_in, 9248, 0, 6144, 1024, WinT, 0, nullptr, nullptr)
        P0_SEG(w_in, 9248, 6176, 1024, 1024, WinT, 6144, nullptr, nullptr)
        P0_SEG(w_in, 9248, 6144, 32, 1024, WinT, 7168, nullptr, nullptr)
        P0_SEG(w_in, 9248, 7200, 2048, 1024, WinT, 7424, nullptr, nullptr)
        P0_SEG(F.in[I_WSSD], 1024, 0, 1024, 2048, (bf16*)(ws + WS_WSSD), 0, F.in[I_GSSD], nullptr)
        P0_SEG(F.in[I_WPOOL] + 0 * 65536, 256, 0, 256, 256, (bf16*)(ws + WS_WPOOL), 0, nullptr, F.in[I_PSCALE] + 0)
        P0_SEG(F.in[I_WPOOL] + 1 * 65536, 256, 0, 256, 256, (bf16*)(ws + WS_WPOOL), 256, nullptr, F.in[I_PSCALE] + 256)
        P0_SEG(F.in[I_WPOOL] + 2 * 65536, 256, 0, 256, 256, (bf16*)(ws + WS_WPOOL), 512, nullptr, F.in[I_PSCALE] + 512)
        P0_SEG(F.in[I_WPOOL] + 3 * 65536, 256, 0, 256, 256, (bf16*)(ws + WS_WPOOL), 768, nullptr, F.in[I_PSCALE] + 768)
        P0_SEG(F.in[I_WO], 1024, 0, 1024, 1024, (bf16*)(ws + WS_WO), 0, nullptr, nullptr)
        P0_SEG(F.in[I_WUP], 4096, 0, 4096, 1024, (bf16*)(ws + WS_WUP), 0, nullptr, nullptr)
        P0_SEG(F.in[I_WDOWN], 1024, 0, 1024, 4096, (bf16*)(ws + WS_WDOWN), 0, nullptr, nullptr)
      }
    }
#undef P0_SEG
    { GAS v4u* z = (GAS v4u*)(WinT + (size_t)7168 * 1024); const int n16 = 256 * 1024 * 2 / 16;
      for (int i = F.bid * NWAVES * 64 + F.tid; i < n16; i += F.G * NWAVES * 64) { const int r = i >> 7, ch = i & 127, c32 = r & 31, slot = (r & ~31) + 16 * ((c32 >> 2) & 1) + 4 * (c32 >> 3) + (c32 & 3);
          if (!(r < 128 && (r & 7) < 2)) z[(ch >> 3) * 2048 + pg8::tile_vec(slot, 8 * (ch & 7))] = (v4u){0u, 0u, 0u, 0u}; } }
}

__device__ __forceinline__ const float* x_row(Frame& F, int m) { return m < MP ? F.in[I_XP] + (size_t)m * DM : F.in[I_XS] + (size_t)(m - MP) * DM; }
__device__ __forceinline__ int mod_row(int m) { return m < MP ? (m >> 12) : 8 + ((m - MP) >> 4); }
__device__ __forceinline__ unsigned dpp_swap1(unsigned x) { return (unsigned)__builtin_amdgcn_update_dpp(0, (int)x, 0xB1, 0xf, 0xf, true); }
__device__ __forceinline__ void ld_bf16_pair(const bf16* row, int lane, int jp, v2u& c0, v2u& c1) {
    const bool odd = (lane & 1) != 0;
    const v4u t = *(const GAS v4u*)(row + 512 * jp + (odd ? 256 + 4 * (lane - 1) : 4 * lane));
    const unsigned r0 = dpp_swap1(odd ? t.x : t.z), r1 = dpp_swap1(odd ? t.y : t.w);
    c0 = odd ? (v2u){r0, r1} : (v2u){t.x, t.y};
    c1 = odd ? (v2u){t.z, t.w} : (v2u){r0, r1};
}
__device__ __forceinline__ void st_bf16_pair(bf16* row, int lane, int jp, const v2u c0, const v2u c1) {
    const bool odd = (lane & 1) != 0;
    const unsigned r0 = dpp_swap1(odd ? c0.x : c1.x), r1 = dpp_swap1(odd ? c0.y : c1.y);
    *(GAS v4u*)(row + 512 * jp + (odd ? 256 + 4 * (lane - 1) : 4 * lane)) = odd ? (v4u){r0, r1, c1.x, c1.y} : (v4u){c0.x, c0.y, r0, r1};
}
__device__ __forceinline__ void u_row(const f32x4 (&v)[4], const f32x4 (&gs)[4], const f32x4 (&sh)[4], bf16* urow, int lane) {
    float s2 = 0.f;
#pragma unroll
    for (int j = 0; j < 4; ++j) s2 += (v[j].x * v[j].x + v[j].y * v[j].y) + (v[j].z * v[j].z + v[j].w * v[j].w);
    const float rstd = rsqrtf(wave_sum(s2) * (1.f / DM) + EPS);
#pragma unroll
    for (int jp = 0; jp < 2; ++jp) { const f32x4 a = v[2 * jp] * rstd * gs[2 * jp] + sh[2 * jp], b = v[2 * jp + 1] * rstd * gs[2 * jp + 1] + sh[2 * jp + 1];
        st_bf16_pair(urow, lane, jp, (v2u){cvt_pk_bf16(a.x, a.y), cvt_pk_bf16(a.z, a.w)}, (v2u){cvt_pk_bf16(b.x, b.y), cvt_pk_bf16(b.z, b.w)}); }
}
__device__ __forceinline__ void p1_u(Frame& F) {
    const int gw = F.bid * NWAVES + F.wave, NGW = F.G * NWAVES, lane = F.lane;
    const float* mod = (const float*)(F.ws + WS_MOD); bf16* U = (bf16*)(F.ws + WS_U);
    const float* gp = F.in[I_GPREMIX];
    for (int m = MP + (NGW - 1 - gw); m < MPAD; m += NGW) {
        if (m >= MR) { GAS v2u* o8 = (GAS v2u*)(U + (size_t)m * DM) + lane;
#pragma unroll
            for (int j = 0; j < 4; ++j) o8[64 * j] = (v2u){0u, 0u};
            continue; }
        const float* md = mod + mod_row(m) * 6144;
        f32x4 gs[4], sh[4], v[4];
        const GAS f32x4* xr = (const GAS f32x4*)x_row(F, m) + lane;
#pragma unroll
        for (int j = 0; j < 4; ++j) { const int k = 4 * lane + 256 * j; v[j] = xr[64 * j]; gs[j] = *(const f32x4*)(gp + k) * (*(const f32x4*)(md + 1024 + k) + 1.0f); sh[j] = *(const f32x4*)(md + k); }
        u_row(v, gs, sh, U + (size_t)m * DM, lane);
    }
    for (int blk = gw; blk < MP / 16; blk += NGW) {
        const int m0 = blk * 16;
        const float* md = mod + mod_row(m0) * 6144;
        f32x4 gs[4], sh[4];
#pragma unroll
        for (int j = 0; j < 4; ++j) { const int k = 4 * lane + 256 * j; gs[j] = *(const f32x4*)(gp + k) * (*(const f32x4*)(md + 1024 + k) + 1.0f); sh[j] = *(const f32x4*)(md + k); }
        for (int r = 0; r < 16; r += 2) {
            f32x4 v0[4], v1[4];
            const GAS f32x4* x0 = (const GAS f32x4*)x_row(F, m0 + r) + lane; const GAS f32x4* x1 = (const GAS f32x4*)x_row(F, m0 + r + 1) + lane;
#pragma unroll
            for (int j = 0; j < 4; ++j) { v0[j] = x0[64 * j]; v1[j] = x1[64 * j]; }
            u_row(v0, gs, sh, U + (size_t)(m0 + r) * DM, lane); u_row(v1, gs, sh, U + (size_t)(m0 + r + 1) * DM, lane);
        }
    }
}

__device__ __forceinline__ void conv8_row(const float (&cw)[4][8], const float (&cb)[8], float (&win)[3][8], const v4u raw, v4u& outp) {
    float x[8] = {bf_lo(raw.x), bf_hi(raw.x), bf_lo(raw.y), bf_hi(raw.y), bf_lo(raw.z), bf_hi(raw.z), bf_lo(raw.w), bf_hi(raw.w)};
    float o[8];
#pragma unroll
    for (int e = 0; e < 8; ++e) { o[e] = silu_f(cb[e] + cw[0][e] * win[0][e] + cw[1][e] * win[1][e] + cw[2][e] * win[2][e] + cw[3][e] * x[e]); win[0][e] = win[1][e]; win[1][e] = win[2][e]; win[2][e] = x[e]; }
    outp = (v4u){cvt_pk_bf16(o[0], o[1]), cvt_pk_bf16(o[2], o[3]), cvt_pk_bf16(o[4], o[5]), cvt_pk_bf16(o[6], o[7])};
}
__device__ __forceinline__ void p2b_conv_bc(Frame& F) {
    bf16* XBC = (bf16*)(F.ws + WS_XBC); const bf16* HALO = (const bf16*)(F.ws + WS_HALO);
    const int tid = F.tid, cg = tid & 63, seg = tid >> 6;
    for (int item = F.bid; item < 256; item += F.G) {
        const int b = item >> 5, q = (item >> 3) & 3, rr = item & 7, col = 2048 + (q * 64 + cg) * 8;
        float cw[4][8], cb[8];
#pragma unroll
        for (int k = 0; k < 4; ++k) { const f32x4 a0 = *(const f32x4*)(F.in[I_CONVW] + k * CONVD + col), a1 = *(const f32x4*)(F.in[I_CONVW] + k * CONVD + col + 4);
            cw[k][0] = a0.x; cw[k][1] = a0.y; cw[k][2] = a0.z; cw[k][3] = a0.w; cw[k][4] = a1.x; cw[k][5] = a1.y; cw[k][6] = a1.z; cw[k][7] = a1.w; }
        { const f32x4 a0 = *(const f32x4*)(F.in[I_CONVB] + col), a1 = *(const f32x4*)(F.in[I_CONVB] + col + 4);
          cb[0] = a0.x; cb[1] = a0.y; cb[2] = a0.z; cb[3] = a0.w; cb[4] = a1.x; cb[5] = a1.y; cb[6] = a1.z; cb[7] = a1.w; }
        bf16* base = XBC + ((size_t)b * SEQ + (size_t)rr * 512 + (size_t)seg * 64) * CONVD + col;
        float win[3][8];
#pragma unroll
        for (int i = 0; i < 3; ++i) { v4u r = (v4u){0u, 0u, 0u, 0u};
            if (seg > 0) r = *(const GAS v4u*)(base - (size_t)(3 - i) * CONVD);
            else if (rr > 0) r = *(const GAS v4u*)(HALO + ((size_t)((b * 8 + rr) * 3 + i)) * 2048 + (col - 2048));
            win[i][0] = bf_lo(r.x); win[i][1] = bf_hi(r.x); win[i][2] = bf_lo(r.y); win[i][3] = bf_hi(r.y); win[i][4] = bf_lo(r.z); win[i][5] = bf_hi(r.z); win[i][6] = bf_lo(r.w); win[i][7] = bf_hi(r.w); }
        asm volatile("s_waitcnt vmcnt(0)" ::: "memory");
        __syncthreads();
        for (int blk = 0; blk < 8; ++blk) {
            v4u rw[8];
#pragma unroll
            for (int i = 0; i < 8; ++i) rw[i] = *(const GAS v4u*)(base + (size_t)(blk * 8 + i) * CONVD);
#pragma unroll
            for (int i = 0; i < 8; ++i) { v4u o; conv8_row(cw, cb, win, rw[i], o); *(GAS v4u*)(base + (size_t)(blk * 8 + i) * CONVD) = o; }
        }
        __syncthreads();
    }
}

constexpr int SS_CM = 0, SS_BM = 17408, SS_BWT = 34816, SS_XT = 53248, SS_XR = 71680, SS_GP = 90112, SS_HB = 108544, SS_SC = 125952, SS_PAR = 9216;
static_assert(SS_SC + 2 * 1280 <= RING_BYTES, "SSD LDS map");
constexpr int SS_XRAW = 132096;
static_assert(SS_XRAW >= MISC_OFF + 128 && SS_XRAW + 72 * 144 <= LDS_BYTES, "SSD raw image");
__device__ __forceinline__ bf16x8 ldfrag(LAS unsigned char* base, int row, int stride, int kbyte) { return *(const LAS bf16x8*)(base + row * stride + kbyte); }
__device__ __forceinline__ v4u pack8f(const float* f) { v4u o; o.x = cvt_pk_bf16(f[0], f[1]); o.y = cvt_pk_bf16(f[2], f[3]); o.z = cvt_pk_bf16(f[4], f[5]); o.w = cvt_pk_bf16(f[6], f[7]); return o; }

template <bool sample> __device__ __forceinline__ void ssd_unit(Frame& F, int b, int h) {
    LAS unsigned char* lds = F.lds;
    const int tid = F.tid, lane = F.lane, w = F.wave, r16 = lane & 15, q = lane >> 4;
    constexpr int CS = 64;
    const int g = h >> 2; constexpr int L = sample ? DSEQ : SEQ, nch = sample ? 1 : SEQ / CS, valid = sample ? DSEQ : CS;
    const size_t m0 = sample ? (size_t)(MP + b * DSEQ) : (size_t)b * SEQ;
    const float a = -__expf(F.in[I_ALOG][h]), Dh = F.in[I_DSKIP][h];
    const bf16* XBC = (const bf16*)(F.ws + WS_XBC); bf16* Zb = (bf16*)(F.ws + WS_Z);
    const float* DT = (const float*)(F.ws + WS_DT);
    const float* hist = F.in[I_CONV] + (size_t)b * 3 * CONVD;
    f32x4 acch[4];
#pragma unroll
    for (int pt = 0; pt < 4; ++pt) {
        if (sample) acch[pt] = *(const f32x4*)(F.in[I_SSM] + (((size_t)(b * NHEAD + h) * 64 + pt * 16 + r16) * 128 + w * 16 + 4 * q));
        else acch[pt] = (f32x4){0.f, 0.f, 0.f, 0.f}; }
    const int pp = tid & 31, xl0 = (tid >> 5) * 4, xcol = h * 64 + 2 * pp;
    float wk[4][2], bb[2];
#pragma unroll
    for (int k = 0; k < 4; ++k) { wk[k][0] = F.in[I_CONVW][k * CONVD + xcol]; wk[k][1] = F.in[I_CONVW][k * CONVD + xcol + 1]; }
    bb[0] = F.in[I_CONVB][xcol]; bb[1] = F.in[I_CONVB][xcol + 1];
    const bool isB = tid < 256; const int cg = tid & 15, bl0 = ((tid >> 4) & 15) * 4, bccol = (isB ? 2048 : 3072) + g * 128 + cg * 8;
    v4u bcraw[4], xr9[2];
    auto load_xraw = [&](int c) {
#pragma unroll
        for (int k = 0; k < 2; ++k) { const int i = k == 0 ? w : 8; const int r = 8 * i + (lane >> 3), t = c * CS - 3 + r, cc = h * 64 + (lane & 7) * 8;
            if (k == 1 && w != 0) break;
            if (r < 67 && t >= 0 && t < L) xr9[k] = *(const GAS v4u*)(XBC + (m0 + t) * CONVD + cc);
            else if (r < 67 && t < 0 && sample) { const float* hp = hist + (size_t)(3 + t) * CONVD + cc; const f32x4 a0 = *(const f32x4*)hp, a1 = *(const f32x4*)(hp + 4);
                xr9[k] = (v4u){cvt_pk_bf16(a0.x, a0.y), cvt_pk_bf16(a0.z, a0.w), cvt_pk_bf16(a1.x, a1.y), cvt_pk_bf16(a1.z, a1.w)}; }
            else xr9[k] = (v4u){0u, 0u, 0u, 0u}; }
    };
    auto write_xraw = [&]() {
        *(LAS v4u*)(lds + SS_XRAW + (8 * w + (lane >> 3)) * 144 + (lane & 7) * 16) = xr9[0];
        if (w == 0) *(LAS v4u*)(lds + SS_XRAW + (64 + (lane >> 3)) * 144 + (lane & 7) * 16) = xr9[1];
    };
    auto load_raw = [&](int c) {
#pragma unroll
        for (int i = 0; i < 4; ++i) { const int t = c * CS + bl0 + i;
            bcraw[i] = (!sample || bl0 + i < valid) ? *(const GAS v4u*)(XBC + (m0 + t) * CONVD + bccol) : (v4u){0u, 0u, 0u, 0u}; }
    };
    auto scalars = [&](int par, float dtl) {
        LAS float* sc = (LAS float*)(lds + SS_SC + par * 1280);
        float x = dtl * a;
#define SSD_DPP_ADD(ctrl, rmask) x += __builtin_bit_cast(float, __builtin_amdgcn_update_dpp(0, __builtin_bit_cast(int, x), ctrl, rmask, 0xf, true))
        SSD_DPP_ADD(0x111, 0xf); SSD_DPP_ADD(0x112, 0xf); SSD_DPP_ADD(0x114, 0xf); SSD_DPP_ADD(0x118, 0xf);
        SSD_DPP_ADD(0x142, 0xa); SSD_DPP_ADD(0x143, 0xc);
#undef SSD_DPP_ADD
        const float aend = __builtin_bit_cast(float, __builtin_amdgcn_readlane(__builtin_bit_cast(int, x), 63));
        sc[lane] = x; sc[64 + lane] = dtl; sc[128 + lane] = __expf(aend - x) * dtl; sc[192 + lane] = __expf(x); if (lane == 0) sc[256] = __expf(aend);
    };
    const int zlt = w & 3, zhh = w >> 2, zlrow = zlt * 16 + r16;
    v2u zraw[2];
    auto load_z = [&](int c) {
#pragma unroll
        for (int j = 0; j < 2; ++j) zraw[j] = (!sample || zlrow < valid) ? *(const GAS v2u*)(Zb + (m0 + (size_t)c * CS + zlrow) * DIN + h * 64 + (2 * zhh + j) * 16 + 4 * q) : (v2u){0u, 0u};
    };
    if constexpr (sample) {
        if (bl0 < valid) {
            float cw[4][8], cb[8], win[3][8];
#pragma unroll
            for (int k = 0; k < 4; ++k) { const f32x4 a0 = *(const f32x4*)(F.in[I_CONVW] + k * CONVD + bccol), a1 = *(const f32x4*)(F.in[I_CONVW] + k * CONVD + bccol + 4);
                cw[k][0] = a0.x; cw[k][1] = a0.y; cw[k][2] = a0.z; cw[k][3] = a0.w; cw[k][4] = a1.x; cw[k][5] = a1.y; cw[k][6] = a1.z; cw[k][7] = a1.w; }
            { const f32x4 a0 = *(const f32x4*)(F.in[I_CONVB] + bccol), a1 = *(const f32x4*)(F.in[I_CONVB] + bccol + 4);
              cb[0] = a0.x; cb[1] = a0.y; cb[2] = a0.z; cb[3] = a0.w; cb[4] = a1.x; cb[5] = a1.y; cb[6] = a1.z; cb[7] = a1.w; }
#pragma unroll
            for (int i = 0; i < 3; ++i) { const int t = bl0 - 3 + i; v4u r;
                if (t >= 0) r = *(const GAS v4u*)(XBC + (m0 + t) * CONVD + bccol);
                else { const float* hp = hist + (size_t)(3 + t) * CONVD + bccol; const f32x4 a0 = *(const f32x4*)hp, a1 = *(const f32x4*)(hp + 4);
                    r = (v4u){cvt_pk_bf16(a0.x, a0.y), cvt_pk_bf16(a0.z, a0.w), cvt_pk_bf16(a1.x, a1.y), cvt_pk_bf16(a1.z, a1.w)}; }
                win[i][0] = bf_lo(r.x); win[i][1] = bf_hi(r.x); win[i][2] = bf_lo(r.y); win[i][3] = bf_hi(r.y); win[i][4] = bf_lo(r.z); win[i][5] = bf_hi(r.z); win[i][6] = bf_lo(r.w); win[i][7] = bf_hi(r.w); }
#pragma unroll
            for (int i = 0; i < 4; ++i) { const v4u raw = *(const GAS v4u*)(XBC + (m0 + bl0 + i) * CONVD + bccol); conv8_row(cw, cb, win, raw, bcraw[i]); }
        } else {
#pragma unroll
            for (int i = 0; i < 4; ++i) bcraw[i] = (v4u){0u, 0u, 0u, 0u}; }
    } else load_raw(0);
    load_z(0);
    load_xraw(0); write_xraw(); if (nch > 1) load_xraw(1);
    float dtn = 0.f;
    if (w == 0) { scalars(0, (!sample || lane < valid) ? DT[(m0 + lane) * 32 + h] : 0.f); if (nch > 1) dtn = DT[(m0 + CS + lane) * 32 + h]; }
    __syncthreads();
    for (int c = 0; c < nch; ++c) {
        const int par = c & 1;
        LAS float* sc = (LAS float*)(lds + SS_SC + par * 1280);
        LAS unsigned char* XT = lds + SS_XT + par * SS_PAR; LAS unsigned char* XR = lds + SS_XR + par * SS_PAR; LAS unsigned char* GP = lds + SS_GP + par * SS_PAR;
        { float xin[7][2];
#pragma unroll
          for (int i = 0; i < 7; ++i) { const unsigned xu = *(const LAS unsigned*)(lds + SS_XRAW + (xl0 + i) * 144 + pp * 4); xin[i][0] = bf_lo(xu); xin[i][1] = bf_hi(xu); }
          float o[2][4];
#pragma unroll
          for (int i = 0; i < 4; ++i)
#pragma unroll
              for (int e = 0; e < 2; ++e) { const float v = bb[e] + wk[0][e] * xin[i][e] + wk[1][e] * xin[i + 1][e] + wk[2][e] * xin[i + 2][e] + wk[3][e] * xin[i + 3][e];
                  o[e][i] = (!sample || xl0 + i < valid) ? silu_f(v) : 0.f; }
#pragma unroll
          for (int e = 0; e < 2; ++e) *(LAS v2u*)(XT + (2 * pp + e) * 144 + xl0 * 2) = (v2u){cvt_pk_bf16(o[e][0], o[e][1]), cvt_pk_bf16(o[e][2], o[e][3])};
#pragma unroll
          for (int i = 0; i < 4; ++i) *(LAS unsigned*)(XR + (xl0 + i) * 144 + pp * 4) = cvt_pk_bf16(o[0][i], o[1][i]);
          if (isB) {
#pragma unroll
              for (int i = 0; i < 4; ++i) *(LAS v4u*)(lds + SS_BM + (bl0 + i) * 272 + cg * 16) = bcraw[i];
              const f32x4 wv = *(const LAS f32x4*)(sc + 128 + bl0);
              const int bwsw = (((bl0 >> 3) ^ (cg >> 1)) << 4) + ((bl0 >> 2) & 1) * 8;
#pragma unroll
              for (int e = 0; e < 4; ++e) {
                  const unsigned u0 = e == 0 ? bcraw[0].x : (e == 1 ? bcraw[0].y : (e == 2 ? bcraw[0].z : bcraw[0].w));
                  const unsigned u1 = e == 0 ? bcraw[1].x : (e == 1 ? bcraw[1].y : (e == 2 ? bcraw[1].z : bcraw[1].w));
                  const unsigned u2 = e == 0 ? bcraw[2].x : (e == 1 ? bcraw[2].y : (e == 2 ? bcraw[2].z : bcraw[2].w));
                  const unsigned u3 = e == 0 ? bcraw[3].x : (e == 1 ? bcraw[3].y : (e == 2 ? bcraw[3].z : bcraw[3].w));
                  *(LAS v2u*)(lds + SS_BWT + (cg * 8 + 2 * e) * 144 + bwsw) = (v2u){cvt_pk_bf16(bf_lo(u0) * wv[0], bf_lo(u1) * wv[1]), cvt_pk_bf16(bf_lo(u2) * wv[2], bf_lo(u3) * wv[3])};
                  *(LAS v2u*)(lds + SS_BWT + (cg * 8 + 2 * e + 1) * 144 + bwsw) = (v2u){cvt_pk_bf16(bf_hi(u0) * wv[0], bf_hi(u1) * wv[1]), cvt_pk_bf16(bf_hi(u2) * wv[2], bf_hi(u3) * wv[3])}; }
          } else {
#pragma unroll
              for (int i = 0; i < 4; ++i) *(LAS v4u*)(lds + SS_CM + (bl0 + i) * 272 + cg * 16) = bcraw[i];
          }
          if (c + 1 < nch) load_raw(c + 1);
        }
#pragma unroll
        for (int pt = 0; pt < 4; ++pt) *(LAS v2u*)(lds + SS_HB + (pt * 16 + r16) * 272 + (w * 16 + 4 * q) * 2) = (v2u){cvt_pk_bf16(acch[pt][0], acch[pt][1]), cvt_pk_bf16(acch[pt][2], acch[pt][3])};
        __syncthreads();
        if (w == 0 && c + 1 < nch) { scalars(par ^ 1, dtn); if (c + 2 < nch) dtn = DT[(m0 + (size_t)(c + 2) * CS + lane) * 32 + h]; }
        if (c + 1 < nch) { write_xraw(); if (c + 2 < nch) load_xraw(c + 2); }
        const int lt = w & 3, hh = w >> 2, lrow = lt * 16 + r16;
        const size_t mrow = m0 + (size_t)c * CS + lrow;
        const bool rowok = !sample || lrow < valid;
        bf16x8 cf[4];
#pragma unroll
        for (int ks = 0; ks < 4; ++ks) cf[ks] = ldfrag(lds + SS_CM, lrow, 272, ks * 64 + q * 16);
#pragma unroll
        for (int j = 0; j < 2; ++j) { const int st = 2 * hh + j; f32x4 d = (f32x4){0.f, 0.f, 0.f, 0.f};
#pragma unroll
            for (int ks = 0; ks < 4; ++ks) d = __builtin_amdgcn_mfma_f32_16x16x32_bf16(ldfrag(lds + SS_BM, st * 16 + r16, 272, ks * 64 + q * 16), cf[ks], d, 0, 0, 0);
            const int s0 = st * 16 + 4 * q; const float al = sc[lrow];
            const f32x4 as = *(const LAS f32x4*)(sc + s0), ds = *(const LAS f32x4*)(sc + 64 + s0);
            float gv[4];
#pragma unroll
            for (int r = 0; r < 4; ++r) gv[r] = (lrow >= s0 + r) ? d[r] * __expf(al - as[r]) * ds[r] : 0.f;
            *(LAS v2u*)(GP + lrow * 144 + s0 * 2) = (v2u){cvt_pk_bf16(gv[0], gv[1]), cvt_pk_bf16(gv[2], gv[3])}; }
        f32x4 yoff[2];
#pragma unroll
        for (int j = 0; j < 2; ++j) { const int pt = 2 * hh + j; f32x4 d = (f32x4){0.f, 0.f, 0.f, 0.f};
#pragma unroll
            for (int ks = 0; ks < 4; ++ks) d = __builtin_amdgcn_mfma_f32_16x16x32_bf16(ldfrag(lds + SS_HB, pt * 16 + r16, 272, ks * 64 + q * 16), cf[ks], d, 0, 0, 0);
            yoff[j] = d; }
        { const float dend = sc[256];
          bf16x8 wf[2];
#pragma unroll
          for (int ks = 0; ks < 2; ++ks) wf[ks] = ldfrag(lds + SS_BWT, w * 16 + r16, 144, ((ks * 4 + q) ^ w) * 16);
#pragma unroll
          for (int pt = 0; pt < 4; ++pt) { acch[pt] = acch[pt] * dend;
#pragma unroll
              for (int ks = 0; ks < 2; ++ks) acch[pt] = __builtin_amdgcn_mfma_f32_16x16x32_bf16(wf[ks], ldfrag(XT, pt * 16 + r16, 144, ks * 64 + q * 16), acch[pt], 0, 0, 0); } }
        __syncthreads();
        { bf16x8 gf[2];
#pragma unroll
          for (int ks = 0; ks < 2; ++ks) gf[ks] = ldfrag(GP, lrow, 144, ks * 64 + q * 16);
          const float el = sc[192 + lrow];
#pragma unroll
          for (int j = 0; j < 2; ++j) { const int pt = 2 * hh + j, p0 = pt * 16 + 4 * q; f32x4 d = (f32x4){0.f, 0.f, 0.f, 0.f};
#pragma unroll
              for (int ks = 0; ks < 2; ++ks) d = __builtin_amdgcn_mfma_f32_16x16x32_bf16(ldfrag(XT, pt * 16 + r16, 144, ks * 64 + q * 16), gf[ks], d, 0, 0, 0);
              const v2u xr = *(const LAS v2u*)(XR + lrow * 144 + p0 * 2);
              const float xv[4] = {bf_lo(xr.x), bf_hi(xr.x), bf_lo(xr.y), bf_hi(xr.y)};
              const float zv[4] = {bf_lo(zraw[j].x), bf_hi(zraw[j].x), bf_lo(zraw[j].y), bf_hi(zraw[j].y)};
              float yz[4];
#pragma unroll
              for (int r = 0; r < 4; ++r) yz[r] = (d[r] + el * yoff[j][r] + Dh * xv[r]) * zv[r];
              if (rowok) *(GAS v2u*)(Zb + mrow * DIN + h * 64 + p0) = (v2u){cvt_pk_bf16(yz[0], yz[1]), cvt_pk_bf16(yz[2], yz[3])}; }
          if (c + 1 < nch) load_z(c + 1); }
    }
    { float* so = F.out + (sample ? OFF_SSM_S : OFF_SSM_P) + (size_t)(b * NHEAD + h) * 64 * 128;
#pragma unroll
      for (int pt = 0; pt < 4; ++pt) *(f32x4*)(so + (size_t)(pt * 16 + r16) * 128 + w * 16 + 4 * q) = acch[pt]; }
    __syncthreads();
}
__device__ __forceinline__ void p3_ssd(Frame& F) {
    for (int u = F.bid; u < 256; u += F.G) ssd_unit<false>(F, u >> 5, u & 31);
    for (int u = F.bid; u < 256; u += F.G) ssd_unit<true>(F, u >> 5, u & 31);
}

__device__ __forceinline__ void p4_norm_pool(Frame& F) {
    const int gw = F.bid * NWAVES + F.wave, NGW = F.G * NWAVES, lane = F.lane;
    bf16* Zb = (bf16*)(F.ws + WS_Z);
    const bool bal = NGW == 2048; const bool heavy = bal && gw >= 2032;
    const int nbase = bal ? (heavy ? 3 : 16) : (MR - gw + NGW - 1) / NGW, nrows = nbase + ((bal && gw < 336) ? 1 : 0);
    auto row_of = [&](int i) -> int { if (i < nbase) return gw + i * NGW; return gw < 208 ? 2032 + (gw & 15) + (3 + (gw >> 4)) * 2048 : MP + (gw - 208); };
    for (int i0 = 0; i0 < nrows; i0 += 2) {
        v4u vv[2][4]; int mrow[2];
#pragma unroll
        for (int r = 0; r < 2; ++r) { mrow[r] = i0 + r < nrows ? row_of(i0 + r) : -1;
            if (mrow[r] >= 0) { const GAS v4u* zr = (const GAS v4u*)(Zb + (size_t)mrow[r] * DIN) + lane;
#pragma unroll
                for (int j = 0; j < 4; ++j) vv[r][j] = zr[64 * j]; } }
#pragma unroll
        for (int r = 0; r < 2; ++r) { const int m = mrow[r]; if (m < 0) continue;
            GAS v4u* zr = (GAS v4u*)(Zb + (size_t)m * DIN) + lane;
#pragma unroll
            for (int j = 0; j < 4; ++j) { const v4u v = vv[r][j];
                float a = bf_lo(v.x) * bf_lo(v.x) + bf_hi(v.x) * bf_hi(v.x) + bf_lo(v.y) * bf_lo(v.y) + bf_hi(v.y) * bf_hi(v.y) + bf_lo(v.z) * bf_lo(v.z) + bf_hi(v.z) * bf_hi(v.z) + bf_lo(v.w) * bf_lo(v.w) + bf_hi(v.w) * bf_hi(v.w);
#pragma unroll
                for (int o = 1; o < 32; o <<= 1) a += __shfl_xor(a, o);
                const float rr = rsqrtf(a * (1.f / 256.f) + EPS);
                v4u w;
                w.x = cvt_pk_bf16(bf_lo(v.x) * rr, bf_hi(v.x) * rr); w.y = cvt_pk_bf16(bf_lo(v.y) * rr, bf_hi(v.y) * rr);
                w.z = cvt_pk_bf16(bf_lo(v.z) * rr, bf_hi(v.z) * rr); w.w = cvt_pk_bf16(bf_lo(v.w) * rr, bf_hi(v.w) * rr);
                zr[64 * j] = w; } }
    }
    const bf16* P = (const bf16*)F.out; bf16* PM = (bf16*)(F.ws + WS_PM);
    const int gt = F.bid * (NWAVES * 64) + F.tid, NGT = F.G * NWAVES * 64;
    for (int it = 0; ; ++it) {
        int idx;
        if (NGT == 131072) { if (it == 0) idx = gt; else if (it == 1 && gt >= 131072 - 1024) idx = 131072 + (gt - (131072 - 1024)); else break; }
        else { idx = gt + it * NGT; if (idx >= 131072 + 1024) break; }
        const bool sample = idx >= 131072; const int id = sample ? idx - 131072 : idx;
        const int cgp = id & 127, b = sample ? (id >> 7) : (id >> 14), rbk = sample ? 0 : ((id >> 7) & 127);
        const int wl = 2 << (cgp >> 5), t0 = rbk * 32, nrow = sample ? DSEQ : 32;
        const size_t mb = sample ? (size_t)(MP + b * DSEQ) : (size_t)b * SEQ;
        const float* hp = F.in[I_POOL] + (size_t)b * 15 * DM + cgp * 8;
        auto ldp = [&](int t, bool on, float* f) {
            if (on && t >= 0) { const v4u v = *(const GAS v4u*)(P + (mb + t) * DM + cgp * 8);
                f[0] = bf_lo(v.x); f[1] = bf_hi(v.x); f[2] = bf_lo(v.y); f[3] = bf_hi(v.y); f[4] = bf_lo(v.z); f[5] = bf_hi(v.z); f[6] = bf_lo(v.w); f[7] = bf_hi(v.w); }
            else if (on && sample) { const float* q = hp + (size_t)(15 + t) * DM; const f32x4 a0 = *(const f32x4*)q, a1 = *(const f32x4*)(q + 4);
                f[0] = a0.x; f[1] = a0.y; f[2] = a0.z; f[3] = a0.w; f[4] = a1.x; f[5] = a1.y; f[6] = a1.z; f[7] = a1.w; }
            else {
#pragma unroll
                for (int e = 0; e < 8; ++e) f[e] = 0.f; }
        };
        float sum[8];
#pragma unroll
        for (int e = 0; e < 8; ++e) sum[e] = 0.f;
        { float h[15][8];
#pragma unroll
          for (int i = 1; i < 16; ++i) ldp(t0 - i, i < wl, h[i - 1]);
#pragma unroll
          for (int i = 0; i < 15; ++i)
#pragma unroll
              for (int e = 0; e < 8; ++e) sum[e] += h[i][e]; }
        for (int tb = t0; tb < t0 + nrow; tb += 8) {
            float cur[8][8], old[8][8];
#pragma unroll
            for (int i = 0; i < 8; ++i) { ldp(tb + i, true, cur[i]); ldp(tb + i - wl + 1, true, old[i]); }
#pragma unroll
            for (int i = 0; i < 8; ++i) { const int t = tb + i;
                const int cnt = sample ? wl : (t + 1 < wl ? t + 1 : wl); const float inv = 1.0f / (float)cnt;
                float o[8];
#pragma unroll
                for (int e = 0; e < 8; ++e) { sum[e] += cur[i][e]; o[e] = sum[e] * inv - cur[i][e]; sum[e] -= old[i][e]; }
                *(GAS v4u*)(PM + (mb + t) * DM + cgp * 8) = pack8f(o); }
        }
    }
}

__device__ __forceinline__ void post_row(const f32x4 (&v)[4], const f32x4 (&bs)[4], const f32x4 (&gg)[4], const f32x4 (&gs2)[4], const f32x4 (&sh2)[4], bool first,
                                         bf16* x1b, bf16* vrow, float* orow, int lane) {
    float s2 = 0.f;
#pragma unroll
    for (int j = 0; j < 4; ++j) s2 += (v[j].x * v[j].x + v[j].y * v[j].y) + (v[j].z * v[j].z + v[j].w * v[j].w);
    const float rstd = rsqrtf(wave_sum(s2) * (1.f / DM) + EPS);
    f32x4 x1[4]; float q2 = 0.f;
#pragma unroll
    for (int j = 0; j < 4; ++j) { x1[j] = bs[j] + gg[j] * (v[j] * rstd);
        q2 += (x1[j].x * x1[j].x + x1[j].y * x1[j].y) + (x1[j].z * x1[j].z + x1[j].w * x1[j].w); }
    if (first) {
        GAS v4u* xw = (GAS v4u*)x1b + lane;
#pragma unroll
        for (int jp = 0; jp < 2; ++jp) xw[64 * jp] = (v4u){cvt_pk_bf16(x1[2 * jp].x, x1[2 * jp].y), cvt_pk_bf16(x1[2 * jp].z, x1[2 * jp].w), cvt_pk_bf16(x1[2 * jp + 1].x, x1[2 * jp + 1].y), cvt_pk_bf16(x1[2 * jp + 1].z, x1[2 * jp + 1].w)};
        const float r2 = rsqrtf(wave_sum(q2) * (1.f / DM) + EPS);
#pragma unroll
        for (int jp = 0; jp < 2; ++jp) { const f32x4 a = x1[2 * jp] * r2 * gs2[2 * jp] + sh2[2 * jp], b = x1[2 * jp + 1] * r2 * gs2[2 * jp + 1] + sh2[2 * jp + 1];
            st_bf16_pair(vrow, lane, jp, (v2u){cvt_pk_bf16(a.x, a.y), cvt_pk_bf16(a.z, a.w)}, (v2u){cvt_pk_bf16(b.x, b.y), cvt_pk_bf16(b.z, b.w)}); }
    } else {
        GAS f32x4* ow = (GAS f32x4*)orow + lane;
#pragma unroll
        for (int j = 0; j < 4; ++j) ow[64 * j] = x1[j];
    }
}
__device__ __forceinline__ void p_post(Frame& F, const bf16* S, bool first, const float* slab, int nsl) {
    const int gw = F.bid * NWAVES + F.wave, NGW = F.G * NWAVES, lane = F.lane;
    const float* mod = (const float*)(F.ws + WS_MOD); bf16* V = (bf16*)(F.ws + WS_U);
    bf16* X1B = (bf16*)(F.ws + WS_Z) + (size_t)MPAD * DM;
    const float* gpost = first ? F.in[I_GPOSTMIX] : F.in[I_GPOSTMLP]; const float* gpre = F.in[I_GPREMLP];
    for (int m = MP + (NGW - 1 - gw); m < MPAD; m += NGW) {
        if (m >= MR) { if (first) { GAS v2u* o8 = (GAS v2u*)(V + (size_t)m * DM) + lane;
#pragma unroll
                for (int j = 0; j < 4; ++j) o8[64 * j] = (v2u){0u, 0u}; }
            continue; }
        const float* md = mod + mod_row(m) * 6144;
        f32x4 gg[4], gs2[4], sh2[4], v[4], bs[4];
#pragma unroll
        for (int j = 0; j < 4; ++j) { const int k = 4 * lane + 256 * j;
            gg[j] = *(const f32x4*)(gpost + k) * *(const f32x4*)(md + (first ? 2048 : 5120) + k);
            if (first) { gs2[j] = *(const f32x4*)(gpre + k) * (*(const f32x4*)(md + 4096 + k) + 1.0f); sh2[j] = *(const f32x4*)(md + 3072 + k); }
            else { gs2[j] = (f32x4){0.f, 0.f, 0.f, 0.f}; sh2[j] = gs2[j]; }
            v[j] = (f32x4){0.f, 0.f, 0.f, 0.f}; }
        for (int ks = 0; ks < nsl; ++ks) { const GAS f32x4* pr = (const GAS f32x4*)(slab + ((size_t)ks * 256 + (m - MP)) * DM) + lane;
#pragma unroll
            for (int j = 0; j < 4; ++j) v[j] += pr[64 * j]; }
        if (first) { const GAS f32x4* br = (const GAS f32x4*)x_row(F, m) + lane;
#pragma unroll
            for (int j = 0; j < 4; ++j) bs[j] = br[64 * j]; }
        else { const GAS v4u* x1r = (const GAS v4u*)(X1B + (size_t)m * DM) + lane;
#pragma unroll
            for (int jp = 0; jp < 2; ++jp) { const v4u t = x1r[64 * jp]; bs[2 * jp] = (f32x4){bf_lo(t.x), bf_hi(t.x), bf_lo(t.y), bf_hi(t.y)}; bs[2 * jp + 1] = (f32x4){bf_lo(t.z), bf_hi(t.z), bf_lo(t.w), bf_hi(t.w)}; } }
        post_row(v, bs, gg, gs2, sh2, first, X1B + (size_t)m * DM, V + (size_t)m * DM, F.out + (size_t)m * DM, lane);
    }
    for (int blk = gw; blk < MP / 16; blk += NGW) {
        const int m0 = blk * 16;
        const float* md = mod + mod_row(m0) * 6144;
        f32x4 gg[4], gs2[4], sh2[4];
#pragma unroll
        for (int j = 0; j < 4; ++j) { const int k = 4 * lane + 256 * j;
            gg[j] = *(const f32x4*)(gpost + k) * *(const f32x4*)(md + (first ? 2048 : 5120) + k);
            if (first) { gs2[j] = *(const f32x4*)(gpre + k) * (*(const f32x4*)(md + 4096 + k) + 1.0f); sh2[j] = *(const f32x4*)(md + 3072 + k); }
            else { gs2[j] = (f32x4){0.f, 0.f, 0.f, 0.f}; sh2[j] = gs2[j]; } }
        for (int r = 0; r < 16; r += 2) {
            f32x4 v[2][4], bs[2][4];
#pragma unroll
            for (int q = 0; q < 2; ++q) { const int m = m0 + r + q;
                {
#pragma unroll
                    for (int jp = 0; jp < 2; ++jp) { v2u c0, c1; ld_bf16_pair(S + (size_t)m * DM, lane, jp, c0, c1);
                        v[q][2 * jp] = (f32x4){bf_lo(c0.x), bf_hi(c0.x), bf_lo(c0.y), bf_hi(c0.y)}; v[q][2 * jp + 1] = (f32x4){bf_lo(c1.x), bf_hi(c1.x), bf_lo(c1.y), bf_hi(c1.y)}; } }
                if (first) { const GAS f32x4* br = (const GAS f32x4*)x_row(F, m) + lane;
#pragma unroll
                    for (int j = 0; j < 4; ++j) bs[q][j] = br[64 * j]; }
                else { const GAS v4u* x1r = (const GAS v4u*)(X1B + (size_t)m * DM) + lane;
#pragma unroll
                    for (int jp = 0; jp < 2; ++jp) { const v4u t = x1r[64 * jp]; bs[q][2 * jp] = (f32x4){bf_lo(t.x), bf_hi(t.x), bf_lo(t.y), bf_hi(t.y)}; bs[q][2 * jp + 1] = (f32x4){bf_lo(t.z), bf_hi(t.z), bf_lo(t.w), bf_hi(t.w)}; } } }
#pragma unroll
            for (int q = 0; q < 2; ++q) { const int m = m0 + r + q;
                post_row(v[q], bs[q], gg, gs2, sh2, first, X1B + (size_t)m * DM, V + (size_t)m * DM, F.out + (size_t)m * DM, lane); }
        }
    }
}

__device__ __forceinline__ void sample_mix_merge(const Frame& F, int j, pg8::bf16_t* MIX, const pg8::bf16_t* GS, const float* slab, unsigned* cnt) {
    if (F.tid == 0) {
        unsigned sp = 0; while (__hip_atomic_load(cnt, RLX_AGENT) < (unsigned)pg8::SAMPLE_ARRIVALS) { __builtin_amdgcn_s_sleep(2); if (++sp > (1u << 22)) break; }
        __builtin_amdgcn_fence(__ATOMIC_ACQUIRE, "agent");
        asm volatile("s_waitcnt vmcnt(0)" ::: "memory");
    }
    __syncthreads();
    const int row = 4 * j + (F.tid >> 7), col = (F.tid & 127) * 8;
    const float* S = slab + (size_t)row * DM + col;
    f32x4 v0 = (f32x4){0.f, 0.f, 0.f, 0.f}, v1 = v0;
#pragma unroll
    for (int k = 0; k < pg8::NSPLIT; ++k) { v0 += *(const f32x4*)(S + (size_t)k * 256 * DM); v1 += *(const f32x4*)(S + (size_t)k * 256 * DM + 4); }
    const v4u gw = *(const v4u*)(GS + (size_t)row * DIN + col);
    pg8::bf16_t* mp = MIX + (size_t)(MP + row) * DM + col; const v4u t = *(const v4u*)mp;
    v0[0] = v0[0] * bf_lo(gw.x) + bf_lo(t.x); v0[1] = v0[1] * bf_hi(gw.x) + bf_hi(t.x); v0[2] = v0[2] * bf_lo(gw.y) + bf_lo(t.y); v0[3] = v0[3] * bf_hi(gw.y) + bf_hi(t.y);
    v1[0] = v1[0] * bf_lo(gw.z) + bf_lo(t.z); v1[1] = v1[1] * bf_hi(gw.z) + bf_hi(t.z); v1[2] = v1[2] * bf_lo(gw.w) + bf_lo(t.w); v1[3] = v1[3] * bf_hi(gw.w) + bf_hi(t.w);
    *(v4u*)mp = (v4u){cvt_pk_bf16(v0[0], v0[1]), cvt_pk_bf16(v0[2], v0[3]), cvt_pk_bf16(v1[0], v1[1]), cvt_pk_bf16(v1[2], v1[3])};
}

constexpr int NPHASE = 14;
__global__ void __launch_bounds__(NWAVES * 64, 2) fwd_kernel(Args args) {
    extern __shared__ __attribute__((aligned(16))) unsigned char lds[];
    Frame F;
    F.lds = (LAS unsigned char*)lds;
    F.tid = threadIdx.x; F.lane = F.tid & 63; F.wave = __builtin_amdgcn_readfirstlane(F.tid >> 6);
    F.G = gridDim.x; F.bid = blockIdx.x;
    F.in = args.in; F.out = args.out; F.ws = args.ws;
    unsigned char* ws = args.ws;
    for (int u = F.tid; u < (LDS_BYTES - LDSCTL_OFF) / 4; u += NWAVES * 64) ((LAS unsigned*)(F.lds + LDSCTL_OFF))[u] = 0u;
    __syncthreads();
    const int lo = args.ph_lo, hi = args.ph_hi;
    const bool multi = (hi - lo) > 1;
    XcdBarrier bar; bar.bar = (unsigned*)(ws + WS_CTL) + CW_BAR; bar.x = 0; bar.st = nullptr;
    if (multi) bar = xcd_barrier_post((unsigned*)(ws + WS_CTL) + CW_BAR, (volatile LAS unsigned*)(F.lds + MISC_OFF) + 8);
#define IN(k) (lo <= (k) && (k) < hi)
#define SEAM(k) do { if (IN(k) && IN((k) + 1)) xcd_barrier(bar); } while (0)
    using namespace pg8;
    bf16_t* U = (bf16_t*)(ws + WS_U); bf16_t* Zb = (bf16_t*)(ws + WS_Z); bf16_t* XBC = (bf16_t*)(ws + WS_XBC); bf16_t* Pb = (bf16_t*)args.out;
    bf16_t* Gb = (bf16_t*)(ws + WS_G); bf16_t* PM = (bf16_t*)(ws + WS_PM); bf16_t* MIXIN = (bf16_t*)(ws + WS_MIXIN);
    float* MIXF = (float*)(ws + WS_Z); bf16_t* HDN = (bf16_t*)(ws + WS_XBC);
    bf16_t* WinT = (bf16_t*)(ws + WS_WIN);

    if (IN(0)) { p0_prologue(F); } SEAM(0);
    if (IN(1)) { p1_u(F); } SEAM(1);
    if (IN(2)) {
        Gemm g{U, WinT, MPAD, N1A, DM, DM, DM, 0}; InProjOrder S; S.init(F.G, F.bid);
        Epi1a E{Zb, XBC, Pb, (float*)(ws + WS_DT), F.in[I_DTB], args.out, (bf16_t*)(ws + WS_GS), (bf16_t*)(ws + WS_HALO)};
        gemm_phase<Epi1a, InProjOrder, true>(F.lds + RING_OFF, g, S, E);
    } SEAM(2);
    if (IN(3)) { p2b_conv_bc(F); } SEAM(3);
    if (IN(4)) { p3_ssd(F); } SEAM(4);
    if (IN(5)) { p4_norm_pool(F); }
    if (IN(6)) {
        Gemm g{U, WinT + (size_t)N1A * DM, MP, N1B, DM, DM, DM, 0}; StaticOrder S; S.init(MP, N1B, F.G, F.bid);
        EpiGateT E{Gb};
        gemm_phase<EpiGateT, StaticOrder, true>(F.lds + RING_OFF, g, S, E);
    } SEAM(6);
    if (IN(7)) {
        Gemm g{PM, (bf16_t*)(ws + WS_WPOOL), MPAD, DM, 256, DM, 256, 256}; StaticOrder S; S.init(MPAD, DM, F.G, F.bid);
        EpiGated<0> E{MIXIN, Gb, 1024, (const bf16_t*)(ws + WS_GS), (float*)(ws + WS_SLAB), (unsigned*)(ws + WS_CTL) + CW_SCNT, Pb};
        gemm_phase<EpiGated<0>, StaticOrder, true>(F.lds + RING_OFF, g, S, E);
    }
    if (IN(8)) {
        Gemm g{Zb, (bf16_t*)(ws + WS_WSSD), MPAD, DM, DIN, DIN, DIN, 0}; SplitOrder S; S.init(4, 4, NSPLIT, DIN / BK / NSPLIT, F.G, F.bid, 32);
        EpiGated<1> E{MIXIN, Gb, 0, (const bf16_t*)(ws + WS_GS), (float*)(ws + WS_SLAB), (unsigned*)(ws + WS_CTL) + CW_SCNT, Pb};
        gemm_phase<EpiGated<1>, SplitOrder, true>(F.lds + RING_OFF, g, S, E);
        if (F.bid >= 32 && F.bid < 64) sample_mix_merge(F, F.bid - 32, MIXIN, (const bf16_t*)(ws + WS_GS), (const float*)(ws + WS_SLAB), (unsigned*)(ws + WS_CTL) + CW_SCNT);
    } SEAM(8);
    if (IN(9)) {
        Gemm g{MIXIN, (bf16_t*)(ws + WS_WO), MPAD, DM, DM, DM, DM, 0}; SplitOrder S; S.init(4, 4, 4, 4, F.G, F.bid);
        EpiBf16S E{(bf16_t*)MIXF, DM, (float*)(ws + WS_SLAB)};
        gemm_phase<EpiBf16S, SplitOrder, true>(F.lds + RING_OFF, g, S, E);
    } SEAM(9);
    if (IN(10)) { p_post(F, (const bf16*)MIXF, true, (const float*)(ws + WS_SLAB), 4); } SEAM(10);
    if (IN(11)) {
        Gemm g{U, (bf16_t*)(ws + WS_WUP), MPAD, DFF, DM, DM, DM, 0}; StaticOrder S; S.init(MPAD, DFF, F.G, F.bid);
        EpiHdnT E{HDN};
        gemm_phase<EpiHdnT, StaticOrder, true>(F.lds + RING_OFF, g, S, E);
    } SEAM(11);
    if (IN(12)) {
        Gemm g{HDN, (bf16_t*)(ws + WS_WDOWN), MPAD, DM, DFF, DFF, DFF, 0}; SplitOrderRev S; S.init(4, 4, 8, 8, F.G, F.bid);
        EpiBf16S E{(bf16_t*)MIXF, DM, (float*)(ws + WS_SLAB)};
        gemm_phase<EpiBf16S, SplitOrderRev, true, true>(F.lds + RING_OFF, g, S, E);
    } SEAM(12);
    if (IN(13)) { p_post(F, (const bf16*)MIXF, false, (const float*)(ws + WS_SLAB), 8); }
#undef IN
#undef SEAM
}


#ifndef MK_PER_PHASE
#define MK_PER_PHASE 0
#endif
extern "C" void kernel_launch(void* const* d_in, const int* in_sizes, int n_in, void* d_out, int out_size, void* d_ws, size_t ws_size, hipStream_t stream) {
    static int grid = 0;
    if (grid == 0) {
        if (n_in != 26 || in_sizes[0] != MP * DM || out_size != 38322176 || ws_size < WS_END) {
            fprintf(stderr, "kernel_launch: unexpected shapes: n_in %d in0 %d out %d ws %zu (need %zu)\n", n_in, n_in > 0 ? in_sizes[0] : -1, out_size, ws_size, (size_t)WS_END); grid = -1; return; }
        int dev = 0, cus = 0, per_cu = 0;
        if (hipGetDevice(&dev) != hipSuccess || hipDeviceGetAttribute(&cus, hipDeviceAttributeMultiprocessorCount, dev) != hipSuccess) { grid = -1; return; }
        if (hipFuncSetAttribute((const void*)fwd_kernel, hipFuncAttributeMaxDynamicSharedMemorySize, LDS_BYTES) != hipSuccess) { fprintf(stderr, "kernel_launch: hipFuncSetAttribute failed\n"); grid = -1; return; }
        if (hipOccupancyMaxActiveBlocksPerMultiprocessor(&per_cu, (const void*)fwd_kernel, NWAVES * 64, LDS_BYTES) != hipSuccess || per_cu < 1) {
            fprintf(stderr, "kernel_launch: occupancy query reports %d blocks per CU\n", per_cu); }
        (void)hipGetLastError();
        grid = cus;
    }
    if (grid < 0) return;
    (void)hipMemsetAsync((char*)d_ws + WS_CTL, 0, CTL_ZERO_BYTES, stream);
    Args a{};
    for (int i = 0; i < 26; ++i) a.in[i] = (const float*)d_in[i];
    a.out = (float*)d_out; a.ws = (unsigned char*)d_ws;
#if MK_PER_PHASE
    for (int p = 0; p < NPHASE; ++p) { a.ph_lo = p; a.ph_hi = p + 1; hipLaunchKernelGGL(fwd_kernel, dim3(grid), dim3(NWAVES * 64), LDS_BYTES, stream, a); }
#else
    a.ph_lo = 0; a.ph_hi = NPHASE;
    hipLaunchKernelGGL(fwd_kernel, dim3(grid), dim3(NWAVES * 64), LDS_BYTES, stream, a);
#endif
}
```
